# Optimizing an MI355X kernel written in HIP

```python
import math
import jax, jax.numpy as jnp
from jax import lax
import numpy as np

D_MODEL = 1024
BATCH = 8
SEQ = 2048
DEPTH = 2

N_META = 16
HEAD_DIM = 64
N_Q_HEADS = 8
N_KV_HEADS = 2
GROUP = N_Q_HEADS // N_KV_HEADS
ATTN_WIDTH = N_Q_HEADS * HEAD_DIM
KV_WIDTH = N_KV_HEADS * HEAD_DIM
WINDOW = 128
BLOCK = 128
CONV_CH = D_MODEL // 2
CONV_WIDTH = 31
N_BUCKETS = 32
MAX_DISTANCE = 128
D_FF = 2816
N_EXPERTS = 8
TOP_K = 2
D_EXPERT = 1408
N_DENSE = (DEPTH + 1) // 2
N_MOE = DEPTH // 2
ALPHA = (2 * DEPTH) ** 0.25
BETA = (8 * DEPTH) ** -0.25
LN_EPS = 1e-5
Q_END = ATTN_WIDTH
K_END = Q_END + KV_WIDTH
V_END = K_END + KV_WIDTH
GLU_END = V_END + 2 * CONV_CH
GA_END = GLU_END + D_MODEL
GC_END = GA_END + D_MODEL
IN_WIDTH = GC_END

kernel_name = "hybrid_swa_conformer_moe_deepnorm"


def layer_norm(x, g, b):
    xf = x.astype(jnp.float32)
    mu = jnp.mean(xf, -1, keepdims=True)
    var = jnp.mean(jnp.square(xf - mu), -1, keepdims=True)
    y = (xf - mu) * lax.rsqrt(var + LN_EPS) * g.astype(jnp.float32) + b.astype(jnp.float32)
    return y.astype(x.dtype)


def rel_bucket(dist):
    n = jnp.maximum(dist, 0)
    max_exact = N_BUCKETS // 2
    nf = jnp.maximum(n, 1).astype(jnp.float32)
    large = max_exact + (jnp.log(nf / max_exact) / math.log(MAX_DISTANCE / max_exact)
                         * (N_BUCKETS - max_exact)).astype(jnp.int32)
    large = jnp.minimum(large, N_BUCKETS - 1)
    return jnp.where(n < max_exact, n, large)


def head_bias(rel_bias, bucket):
    b = rel_bias.astype(jnp.float32)[bucket]
    b = jnp.moveaxis(b, -1, -3)
    return b.reshape(b.shape[:-3] + (N_KV_HEADS, GROUP) + b.shape[-2:])


def sink_softmax(s, sink):
    m = jnp.maximum(jnp.max(s, -1, keepdims=True), sink)
    p = jnp.exp(s - m)
    return p / (jnp.sum(p, -1, keepdims=True) + jnp.exp(sink - m))


def sliding_window_attention(q, k, v, sinks, rel_bias):
    B, L = q.shape[:2]
    S = L - N_META
    nb = S // BLOCK
    scale = HEAD_DIM ** -0.5
    sink = sinks.astype(jnp.float32).reshape(N_KV_HEADS, GROUP)[:, :, None, None]

    qm = q[:, :N_META].reshape(B, N_META, N_KV_HEADS, GROUP, HEAD_DIM)
    km, vm = k[:, :N_META], v[:, :N_META]

    pos_m = jnp.arange(N_META)
    dist_mm = pos_m[:, None] - pos_m[None, :]
    s_mm = jnp.einsum('bqhgd,bkhd->bhgqk', qm, km).astype(jnp.float32) * scale
    s_mm = s_mm + head_bias(rel_bias, rel_bucket(dist_mm))
    s_mm = jnp.where(dist_mm >= 0, s_mm, -jnp.inf)
    p_mm = sink_softmax(s_mm, sink).astype(v.dtype)
    o_m = jnp.einsum('bhgqk,bkhd->bqhgd', p_mm, vm).reshape(B, N_META, ATTN_WIDTH)

    qr = q[:, N_META:].reshape(B, nb, BLOCK, N_KV_HEADS, GROUP, HEAD_DIM)
    kr = k[:, N_META:].reshape(B, nb, BLOCK, N_KV_HEADS, HEAD_DIM)
    vr = v[:, N_META:].reshape(B, nb, BLOCK, N_KV_HEADS, HEAD_DIM)
    zpad = jnp.zeros_like(kr[:, :1])
    kb = jnp.concatenate([jnp.concatenate([zpad, kr[:, :-1]], 1), kr], 2)
    vb = jnp.concatenate([jnp.concatenate([zpad, vr[:, :-1]], 1), vr], 2)

    a = jnp.arange(BLOCK)
    kk = jnp.arange(2 * BLOCK)
    blk = jnp.arange(nb)
    dist_band = BLOCK + a[:, None] - kk[None, :]
    mask_band = ((dist_band >= 0) & (dist_band < WINDOW))[None] & \
        ((blk[:, None, None] > 0) | (kk[None, None, :] >= BLOCK))
    q_pos = N_META + blk[:, None] * BLOCK + a[None, :]
    dist_meta = q_pos[:, :, None] - pos_m[None, None, :]

    s_band = jnp.einsum('bnqhgd,bnkhd->bnhgqk', qr, kb).astype(jnp.float32) * scale
    s_band = s_band + head_bias(rel_bias, rel_bucket(dist_band))
    s_band = jnp.where(mask_band[None, :, None, None], s_band, -jnp.inf)
    s_meta = jnp.einsum('bnqhgd,bmhd->bnhgqm', qr, km).astype(jnp.float32) * scale
    s_meta = s_meta + head_bias(rel_bias, rel_bucket(dist_meta))
    p = sink_softmax(jnp.concatenate([s_meta, s_band], -1), sink).astype(v.dtype)
    o_r = jnp.einsum('bnhgqm,bmhd->bnqhgd', p[..., :N_META], vm) + \
        jnp.einsum('bnhgqk,bnkhd->bnqhgd', p[..., N_META:], vb)
    o_r = o_r.reshape(B, S, ATTN_WIDTH)
    return jnp.concatenate([o_m, o_r], 1)


def conformer_conv(u, dw, db, g, b):
    val, gate = jnp.split(u, 2, axis=-1)
    h = val * jax.nn.sigmoid(gate)
    h = lax.conv_general_dilated(h, dw[:, None, :].astype(h.dtype), window_strides=(1,),
                                 padding=[(CONV_WIDTH - 1, 0)],
                                 dimension_numbers=('NWC', 'WIO', 'NWC'),
                                 feature_group_count=CONV_CH) + db
    h = layer_norm(h, g, b)
    return jax.nn.silu(h)


def swiglu(t, wg, wu, wd):
    return (jax.nn.silu(t @ wg) * (t @ wu)) @ wd


def moe_swiglu(h, router, wg, wu, wd):
    B, L, D = h.shape
    t = h.reshape(B * L, D)
    logits = (t @ router).astype(jnp.float32)
    vals, idx = lax.top_k(logits, TOP_K)
    gates = jax.nn.softmax(vals, axis=-1)
    combine = jnp.sum(jax.nn.one_hot(idx, N_EXPERTS, dtype=jnp.float32) * gates[..., None], 1)
    out = jnp.zeros_like(t)
    for e in range(N_EXPERTS):
        out = out + combine[:, e:e + 1].astype(t.dtype) * swiglu(t, wg[e], wu[e], wd[e])
    return out.reshape(B, L, D)


def setup_inputs(seed: int = 0) -> dict:
    key = jax.random.key(seed)
    ks = iter(jax.random.split(key, 32))
    n = lambda shape, s: jax.random.normal(next(ks), shape, jnp.float32) * s
    D = D_MODEL
    return {
        "x": n((BATCH, SEQ, D), 1.0),
        "meta_tokens": n((N_META, D), 1.0),
        "emb_ln_g": 1.0 + n((D,), 0.02),
        "emb_ln_b": n((D,), 0.02),
        "rel_bias": n((N_BUCKETS, N_Q_HEADS), 0.5),
        "w_in": n((DEPTH, D, IN_WIDTH), D ** -0.5),
        "conv_dw": n((DEPTH, CONV_WIDTH, CONV_CH), CONV_WIDTH ** -0.5),
        "conv_b": n((DEPTH, CONV_CH), 0.02),
        "conv_ln_g": 1.0 + n((DEPTH, CONV_CH), 0.02),
        "conv_ln_b": n((DEPTH, CONV_CH), 0.02),
        "sinks": n((DEPTH, N_Q_HEADS), 0.5),
        "w_attn_proj": n((DEPTH, ATTN_WIDTH, D), ATTN_WIDTH ** -0.5),
        "w_conv_proj": n((DEPTH, CONV_CH, D), CONV_CH ** -0.5),
        "w_out": n((DEPTH, D, D), BETA * D ** -0.5),
        "ln1_g": 1.0 + n((DEPTH, D), 0.02),
        "ln1_b": n((DEPTH, D), 0.02),
        "ffn_w_gate": n((N_DENSE, D, D_FF), D ** -0.5),
        "ffn_w_up": n((N_DENSE, D, D_FF), D ** -0.5),
        "ffn_w_down": n((N_DENSE, D_FF, D), BETA * D_FF ** -0.5),
        "router": n((N_MOE, D, N_EXPERTS), D ** -0.5),
        "moe_w_gate": n((N_MOE, N_EXPERTS, D, D_EXPERT), D ** -0.5),
        "moe_w_up": n((N_MOE, N_EXPERTS, D, D_EXPERT), D ** -0.5),
        "moe_w_down": n((N_MOE, N_EXPERTS, D_EXPERT, D), BETA * D_EXPERT ** -0.5),
        "ln2_g": 1.0 + n((DEPTH, D), 0.02),
        "ln2_b": n((DEPTH, D), 0.02),
    }


def reference(x, meta_tokens, emb_ln_g, emb_ln_b, rel_bias, w_in, conv_dw, conv_b,
              conv_ln_g, conv_ln_b, sinks, w_attn_proj, w_conv_proj, w_out, ln1_g, ln1_b,
              ffn_w_gate, ffn_w_up, ffn_w_down, router, moe_w_gate, moe_w_up, moe_w_down,
              ln2_g, ln2_b):
    B = x.shape[0]
    meta = jnp.broadcast_to(meta_tokens[None].astype(x.dtype), (B, N_META, D_MODEL))
    h = layer_norm(jnp.concatenate([meta, x], axis=1), emb_ln_g, emb_ln_b)
    L = h.shape[1]
    for i in range(DEPTH):
        u = h @ w_in[i]
        q = u[..., :Q_END].reshape(B, L, N_Q_HEADS, HEAD_DIM)
        k = u[..., Q_END:K_END].reshape(B, L, N_KV_HEADS, HEAD_DIM)
        v = u[..., K_END:V_END].reshape(B, L, N_KV_HEADS, HEAD_DIM)
        y_attn = sliding_window_attention(q, k, v, sinks[i], rel_bias) @ w_attn_proj[i]
        y_conv = conformer_conv(u[..., V_END:GLU_END], conv_dw[i], conv_b[i],
                                conv_ln_g[i], conv_ln_b[i]) @ w_conv_proj[i]
        mix = (jax.nn.sigmoid(u[..., GLU_END:GA_END]) * y_attn
               + jax.nn.sigmoid(u[..., GA_END:GC_END]) * y_conv) @ w_out[i]
        h = layer_norm(ALPHA * h + mix, ln1_g[i], ln1_b[i])
        j = i // 2
        if i % 2 == 0:
            f = swiglu(h, ffn_w_gate[j], ffn_w_up[j], ffn_w_down[j])
        else:
            f = moe_swiglu(h, router[j], moe_w_gate[j], moe_w_up[j], moe_w_down[j])
        h = layer_norm(ALPHA * h + f, ln2_g[i], ln2_b[i])
    return h[:, N_META:]
```

```cpp
#include <hip/hip_runtime.h>
#include <cstdio>
#include <cstdint>
#include <cmath>
namespace pg8 {
#define PG8_LAS __attribute__((address_space(3)))
typedef unsigned short bf16_t;
typedef short bf16x8 __attribute__((ext_vector_type(8)));
typedef float f32x4 __attribute__((ext_vector_type(4)));
typedef unsigned u32x4 __attribute__((ext_vector_type(4)));
constexpr int BM = 256, BK = 64, HALF = 128, HTB = HALF * BK * 2  , STAGE_BYTES = 8 * HTB, NXCD = 8, WGM = 8;

__host__ __device__ __forceinline__ int lds_byte(int r, int c) { const int st = (r >> 4) * 2 + (c >> 5), rr = r & 15, cc = c & 31, ob = rr * 64 + cc * 2; return st * 1024 + (ob ^ (((ob >> 9) & 1) << 5)); }
__host__ __device__ __forceinline__ void stage_rc(int b, int& R, int& C) { const int st = b / 1024, sb = b % 1024, swz = sb ^ (((sb >> 9) & 1) << 5); R = (st >> 1) * 16 + swz / 64; C = (st & 1) * 32 + (swz % 64) / 2; }
__host__ __device__ __forceinline__ int perm32(int rho) { const int n = rho >> 4, i = rho & 15; return 8 * (i >> 2) + 4 * n + (i & 3); }

struct Unit { int pm, pn; };
struct Gemm { const bf16_t* A; const bf16_t* Bt; int M, N, K; };

struct StaticOrder {
    int nM, nN, nwg, G, c;
    __host__ __device__ void init(int M, int N, int G_, int c_) { nM = M / BM; nN = N / BM; nwg = nM * nN; G = G_; c = c_; }
    __host__ __device__ bool next(int i, Unit& u) const {
        const long L = (long)i * G + c; if (L >= nwg) return false;
        int wgid = (int)L; { const int q = nwg / NXCD, r = nwg % NXCD, xcd = wgid % NXCD, off = wgid / NXCD; wgid = (xcd < r ? xcd * (q + 1) : r * (q + 1) + (xcd - r) * q) + off; }
        const int nig = WGM * nN, gid = wgid / nig, fm = gid * WGM, gsz = (nM - fm) < WGM ? (nM - fm) : WGM;
        u.pm = fm + ((wgid % nig) % gsz); u.pn = (wgid % nig) / gsz; return true;
    }
    __device__ __forceinline__ void a_ready(const Unit&) const {}
    __device__ __forceinline__ void done(const Unit&) const {}
};

__device__ __forceinline__ unsigned cvt_pk_bf16(float lo, float hi) { unsigned r; asm volatile("v_cvt_pk_bf16_f32 %0, %1, %2" : "=v"(r) : "v"(lo), "v"(hi)); return r; }
typedef float f32x2 __attribute__((ext_vector_type(2)));
typedef unsigned u32x2 __attribute__((ext_vector_type(2)));
__device__ __forceinline__ float bf_lo(unsigned w) { return __builtin_bit_cast(float, w << 16); }
__device__ __forceinline__ float bf_hi(unsigned w) { return __builtin_bit_cast(float, w & 0xffff0000u); }
__device__ __forceinline__ float sigm(float x) { return __builtin_amdgcn_rcpf(1.0f + __builtin_amdgcn_exp2f(-1.4426950408889634f * x)); }
__device__ __forceinline__ u32x4 pack8(const f32x4 a, const f32x4 b) { u32x4 w; w.x = cvt_pk_bf16(a[0], a[1]); w.y = cvt_pk_bf16(a[2], a[3]); w.z = cvt_pk_bf16(b[0], b[1]); w.w = cvt_pk_bf16(b[2], b[3]); return w; }
__device__ __forceinline__ void unpack8(const u32x4 w, f32x4& a, f32x4& b) { a = (f32x4){bf_lo(w.x), bf_hi(w.x), bf_lo(w.y), bf_hi(w.y)}; b = (f32x4){bf_lo(w.z), bf_hi(w.z), bf_lo(w.w), bf_hi(w.w)}; }

struct EpiWin {
    static constexpr bool PERM = true, AFTER_DRAIN = false;
    bf16_t *Q, *Kb, *Vb, *GLU, *SGA, *SGC;
    __device__ __forceinline__ void operator()(const f32x4 (&acc)[2][2][4][2], const Unit& u, int wr, int wc, int fr, int fq) const {
        const int row0 = u.pm * BM + wr * 64 + fr, pn = u.pn, cin = wc * 32 + 8 * fq;
#pragma unroll
        for (int ai = 0; ai < 2; ++ai)
#pragma unroll
            for (int m = 0; m < 4; ++m) { const size_t row = (size_t)(row0 + ai * HALF + m * 16);
#pragma unroll
                for (int bj = 0; bj < 2; ++bj) { const f32x4 v0 = acc[ai][bj][m][0], v1 = acc[ai][bj][m][1];
                    if (pn < 2) { *(u32x4*)(Q + row * 512 + pn * 256 + bj * HALF + cin) = pack8(v0, v1); }
                    else if (pn == 2) { bf16_t* base = bj ? Vb : Kb; *(u32x4*)(base + row * 128 + cin) = pack8(v0, v1); }
                    else if (pn < 7) { u32x2 w; w.x = cvt_pk_bf16(v0[0] * sigm(v0[1]), v0[2] * sigm(v0[3])); w.y = cvt_pk_bf16(v1[0] * sigm(v1[1]), v1[2] * sigm(v1[3]));
                        *(u32x2*)(GLU + row * 512 + (pn - 3) * 128 + bj * 64 + (cin >> 1)) = w; }
                    else { const f32x4 s0 = (f32x4){sigm(v0[0]), sigm(v0[1]), sigm(v0[2]), sigm(v0[3])}, s1 = (f32x4){sigm(v1[0]), sigm(v1[1]), sigm(v1[2]), sigm(v1[3])};
                        bf16_t* base = pn < 11 ? SGA + (pn - 7) * 256 : SGC + (pn - 11) * 256; *(u32x4*)(base + row * 1024 + bj * HALF + cin) = pack8(s0, s1); } } }
    }
};
struct EpiGate {
    static constexpr bool PERM = true, AFTER_DRAIN = false;
    bf16_t* G; const bf16_t* S; int add;
    __device__ __forceinline__ void operator()(const f32x4 (&acc)[2][2][4][2], const Unit& u, int wr, int wc, int fr, int fq) const {
        const int row0 = u.pm * BM + wr * 64 + fr, col0 = u.pn * BM + wc * 32 + 8 * fq;
#pragma unroll
        for (int ai = 0; ai < 2; ++ai)
#pragma unroll
            for (int m = 0; m < 4; ++m) { const size_t off = (size_t)(row0 + ai * HALF + m * 16) * 1024 + col0;
#pragma unroll
                for (int bj = 0; bj < 2; ++bj) { f32x4 s0, s1; unpack8(*(const u32x4*)(S + off + bj * HALF), s0, s1);
                    f32x4 o0 = s0 * acc[ai][bj][m][0], o1 = s1 * acc[ai][bj][m][1];
                    if (add) { f32x4 g0, g1; unpack8(*(const u32x4*)(G + off + bj * HALF), g0, g1); o0 += g0; o1 += g1; }
                    *(u32x4*)(G + off + bj * HALF) = pack8(o0, o1); }
                asm volatile("" ::: "memory"); }
    }
};
struct EpiResF32 {
    static constexpr bool PERM = false, AFTER_DRAIN = false;
    float* Z; const bf16_t* H; const float* cw; int mode; float alpha;
    __device__ __forceinline__ void operator()(const f32x4 (&acc)[2][2][4][2], const Unit& u, int wr, int wc, int fr, int fq) const {
        const int row0 = u.pm * BM + wr * 64 + fr, col0 = u.pn * BM + wc * 32 + 4 * fq;
#pragma unroll
        for (int ai = 0; ai < 2; ++ai)
#pragma unroll
            for (int m = 0; m < 4; ++m) { const int row = row0 + ai * HALF + m * 16; const size_t off = (size_t)row * 1024 + col0;
                const float c = mode ? cw[row] : 1.0f;
#pragma unroll
                for (int bj = 0; bj < 2; ++bj)
#pragma unroll
                    for (int n = 0; n < 2; ++n) { const size_t o = off + bj * HALF + n * 16; f32x4 base;
                        if (mode == 2) base = *(const f32x4*)(Z + o);
                        else { const u32x2 hw = *(const u32x2*)(H + o); base = (f32x4){bf_lo(hw.x), bf_hi(hw.x), bf_lo(hw.y), bf_hi(hw.y)} * alpha; }
                        *(f32x4*)(Z + o) = base + acc[ai][bj][m][n] * c; }
                asm volatile("" ::: "memory"); }
    }
};
struct EpiSwiGLU {
    static constexpr bool PERM = true, AFTER_DRAIN = false;
    bf16_t* O; int ldc;
    __device__ __forceinline__ void operator()(const f32x4 (&acc)[2][2][4][2], const Unit& u, int wr, int wc, int fr, int fq) const {
        const int row0 = u.pm * BM + wr * 64 + fr, col0 = (u.pn * BM + wc * 32 + 8 * fq) >> 1;
#pragma unroll
        for (int ai = 0; ai < 2; ++ai)
#pragma unroll
            for (int m = 0; m < 4; ++m) { bf16_t* rowp = O + (size_t)(row0 + ai * HALF + m * 16) * ldc + col0;
#pragma unroll
                for (int bj = 0; bj < 2; ++bj) { const f32x4 v0 = acc[ai][bj][m][0], v1 = acc[ai][bj][m][1]; u32x2 w;
                    w.x = cvt_pk_bf16(v0[0] * sigm(v0[0]) * v0[1], v0[2] * sigm(v0[2]) * v0[3]); w.y = cvt_pk_bf16(v1[0] * sigm(v1[0]) * v1[1], v1[2] * sigm(v1[2]) * v1[3]);
                    *(u32x2*)(rowp + bj * 64) = w; } }
    }
};

template <class Epi, class Sched, bool ALIGN_EPI = false, bool SP2 = false>
__device__ __forceinline__ void gemm_phase(PG8_LAS unsigned char* lds, const Gemm g, const Sched& S, const Epi& E) {
    int tid_ = threadIdx.x; asm volatile("" : "+v"(tid_));
    const int tid = tid_, wid = __builtin_amdgcn_readfirstlane(tid >> 6), lane = tid & 63, wr = wid >> 2, wc = wid & 3, fr = lane & 15, fq = lane >> 4;
    const int K = g.K, nt = K / BK;
    unsigned voffA[2], voffB[2];
#pragma unroll
    for (int i = 0; i < 2; ++i) { int R, C; stage_rc(tid * 16 + i * 8192, R, C); const int Rb = Epi::PERM ? ((R & ~31) + perm32(R & 31)) : R;
        voffA[i] = (unsigned)(R * K + C) * 2u; voffB[i] = (unsigned)(Rb * K + C) * 2u; }
    const size_t kstep = (size_t)(BK * 2);
    const size_t hstep = (size_t)HALF * K * 2;
    const size_t tstep = 2 * hstep;
    const unsigned ldsw = (unsigned)wid * 1024u;
    const int aoff = lds_byte(wr * 64 + fr, fq * 8), boff = lds_byte(wc * 32 + fr, fq * 8);
#define PG8_SA(b, h) (((b) * 2 + (h)) * HTB)
#define PG8_SB(b, h) ((4 + (b) * 2 + (h)) * HTB)
#define PG8_STAGE(bufoff, gbase, voff) do { _Pragma("unroll") for (int _i = 0; _i < 2; ++_i) \
        __builtin_amdgcn_global_load_lds((const unsigned*)((const char*)(gbase) + (voff)[_i]), (PG8_LAS unsigned*)(lds + (bufoff) + ldsw + _i * 8192), 16, 0, 0); } while (0)
#define PG8_LDA(dst, b, h) do { _Pragma("unroll") for (int m = 0; m < 4; ++m) _Pragma("unroll") for (int k = 0; k < 2; ++k) dst[m][k] = *(const PG8_LAS bf16x8*)(lds + PG8_SA(b, h) + aoff + m * 2048 + k * 1024); } while (0)
#define PG8_LDB(dst, b, h) do { _Pragma("unroll") for (int n = 0; n < 2; ++n) _Pragma("unroll") for (int k = 0; k < 2; ++k) dst[n][k] = *(const PG8_LAS bf16x8*)(lds + PG8_SB(b, h) + boff + n * 2048 + k * 1024); } while (0)
#define PG8_MMA(ai, bj, At, Bt) do { __builtin_amdgcn_s_setprio(1); _Pragma("unroll") for (int m = 0; m < 4; ++m) _Pragma("unroll") for (int n = 0; n < 2; ++n) _Pragma("unroll") for (int k = 0; k < 2; ++k) \
        acc[ai][bj][m][n] = __builtin_amdgcn_mfma_f32_16x16x32_bf16(Bt[n][k], At[m][k], acc[ai][bj][m][n], 0, 0, 0); __builtin_amdgcn_s_setprio(0); } while (0)
#define PG8_WAIT_V(n) asm volatile("s_waitcnt vmcnt(" #n ")" ::: "memory")
#define PG8_WAIT_L(n) asm volatile("s_waitcnt lgkmcnt(" #n ")" ::: "memory")
#define PG8_BAR __builtin_amdgcn_s_barrier()
#define PG8_SCHED __builtin_amdgcn_sched_barrier(0)
    Unit cur, nxt; int ui = 0;
    if (!S.next(0, cur)) return;
    f32x4 acc[2][2][4][2];
#pragma unroll
    for (int a = 0; a < 2; ++a)
#pragma unroll
        for (int b = 0; b < 2; ++b)
#pragma unroll
            for (int m = 0; m < 4; ++m)
#pragma unroll
                for (int n = 0; n < 2; ++n) acc[a][b][m][n] = (f32x4){0.f, 0.f, 0.f, 0.f};
    bf16x8 At[4][2], B0[2][2], B1[2][2];
    const char* cA = (const char*)g.A + (size_t)cur.pm * tstep; const char* cB = (const char*)g.Bt + (size_t)cur.pn * tstep;
    S.a_ready(cur);
    if constexpr (SP2) {
        PG8_STAGE(PG8_SB(0, 0), cB, voffB); PG8_STAGE(PG8_SB(0, 1), cB + hstep, voffB); PG8_STAGE(PG8_SA(0, 0), cA, voffA); PG8_STAGE(PG8_SA(0, 1), cA + hstep, voffA);
        if (wr == 1) PG8_BAR;
        PG8_WAIT_V(2); PG8_BAR;
        PG8_STAGE(PG8_SB(1, 0), cB + kstep, voffB); PG8_STAGE(PG8_SA(1, 0), cA + kstep, voffA); PG8_STAGE(PG8_SB(1, 1), cB + hstep + kstep, voffB);
        PG8_WAIT_V(6); PG8_BAR;
    } else {
        PG8_STAGE(PG8_SB(0, 0), cB, voffB); PG8_STAGE(PG8_SA(0, 0), cA, voffA); PG8_STAGE(PG8_SB(0, 1), cB + hstep, voffB); PG8_STAGE(PG8_SA(0, 1), cA + hstep, voffA);
        if (wr == 1) PG8_BAR;
        PG8_WAIT_V(4); PG8_BAR;
        PG8_STAGE(PG8_SB(1, 0), cB + kstep, voffB); PG8_STAGE(PG8_SA(1, 0), cA + kstep, voffA); PG8_STAGE(PG8_SB(1, 1), cB + hstep + kstep, voffB);
        PG8_WAIT_V(6); PG8_BAR;
    }
    for (;;) {
        const bool has_next = S.next(ui + 1, nxt);
        const char* nA = has_next ? (const char*)g.A + (size_t)nxt.pm * tstep : cA; const char* nB = has_next ? (const char*)g.Bt + (size_t)nxt.pn * tstep : cB;
        for (int t = 0; t < nt; t += 2) {
            const bool last = (t == nt - 2);
            const char* a1 = cA + (size_t)(t + 1) * kstep;
            const char* a2 = last ? nA : cA + (size_t)(t + 2) * kstep; const char* b2 = last ? nB : cB + (size_t)(t + 2) * kstep;
            const char* a3 = a2 + kstep; const char* b3 = b2 + kstep;
            if (last && has_next) S.a_ready(nxt);
            if constexpr (SP2) {
            PG8_LDB(B0, 0, 0); PG8_LDB(B1, 0, 1); PG8_SCHED; PG8_LDA(At, 0, 0); PG8_STAGE(PG8_SA(1, 1), a1 + hstep, voffA);
            PG8_WAIT_V(8); PG8_WAIT_L(0); PG8_BAR; PG8_MMA(0, 0, At, B0); PG8_MMA(0, 1, At, B1); PG8_BAR; PG8_SCHED;
            PG8_LDA(At, 0, 1); PG8_STAGE(PG8_SB(0, 0), b2, voffB); PG8_STAGE(PG8_SB(0, 1), b2 + hstep, voffB); PG8_STAGE(PG8_SA(0, 0), a2, voffA);
            PG8_WAIT_V(8); PG8_WAIT_L(0); PG8_BAR; PG8_MMA(1, 0, At, B0); PG8_MMA(1, 1, At, B1); PG8_BAR; PG8_SCHED;
            PG8_LDB(B0, 1, 0); PG8_LDB(B1, 1, 1); PG8_SCHED; PG8_LDA(At, 1, 0); PG8_STAGE(PG8_SA(0, 1), a2 + hstep, voffA);
            PG8_WAIT_V(8); PG8_WAIT_L(0); PG8_BAR; PG8_MMA(0, 0, At, B0); PG8_MMA(0, 1, At, B1); PG8_BAR; PG8_SCHED;
            PG8_LDA(At, 1, 1); PG8_STAGE(PG8_SB(1, 0), b3, voffB); PG8_STAGE(PG8_SB(1, 1), b3 + hstep, voffB); PG8_STAGE(PG8_SA(1, 0), a3, voffA);
            PG8_WAIT_V(8); PG8_WAIT_L(0); PG8_BAR; PG8_MMA(1, 0, At, B0); PG8_MMA(1, 1, At, B1); PG8_BAR; PG8_SCHED;
            } else {
            PG8_LDB(B0, 0, 0); PG8_SCHED; PG8_LDA(At, 0, 0); PG8_STAGE(PG8_SA(1, 1), a1 + hstep, voffA);
            PG8_WAIT_L(8); PG8_BAR; PG8_WAIT_L(0); PG8_MMA(0, 0, At, B0); PG8_BAR; PG8_SCHED;
            PG8_LDB(B1, 0, 1); PG8_STAGE(PG8_SB(0, 0), b2, voffB);
            PG8_BAR; PG8_WAIT_L(0); PG8_MMA(0, 1, At, B1); PG8_BAR;
            PG8_LDA(At, 0, 1); PG8_STAGE(PG8_SA(0, 0), a2, voffA);
            PG8_BAR; PG8_WAIT_L(0); PG8_MMA(1, 0, At, B0); PG8_BAR; PG8_SCHED;
            PG8_STAGE(PG8_SB(0, 1), b2 + hstep, voffB);
            PG8_WAIT_V(6); PG8_BAR; PG8_MMA(1, 1, At, B1); PG8_BAR;
            PG8_LDB(B0, 1, 0); PG8_SCHED; PG8_LDA(At, 1, 0); PG8_STAGE(PG8_SA(0, 1), a2 + hstep, voffA);
            PG8_WAIT_L(8); PG8_BAR; PG8_WAIT_L(0); PG8_MMA(0, 0, At, B0); PG8_BAR; PG8_SCHED;
            PG8_LDB(B1, 1, 1); PG8_STAGE(PG8_SB(1, 0), b3, voffB);
            PG8_BAR; PG8_WAIT_L(0); PG8_MMA(0, 1, At, B1); PG8_BAR;
            PG8_LDA(At, 1, 1); PG8_STAGE(PG8_SA(1, 0), a3, voffA);
            PG8_BAR; PG8_WAIT_L(0); PG8_MMA(1, 0, At, B0); PG8_BAR; PG8_SCHED;
            PG8_STAGE(PG8_SB(1, 1), b3 + hstep, voffB);
            PG8_WAIT_V(6); PG8_BAR; PG8_MMA(1, 1, At, B1); PG8_BAR;
            }
        }
        if constexpr (ALIGN_EPI) { if (wr == 0) PG8_BAR; }
        if constexpr (!Epi::AFTER_DRAIN) { E(acc, cur, wr, wc, fr, fq); S.done(cur); }
        if (!has_next) break;
#pragma unroll
        for (int a = 0; a < 2; ++a)
#pragma unroll
            for (int b = 0; b < 2; ++b)
#pragma unroll
                for (int m = 0; m < 4; ++m)
#pragma unroll
                    for (int n = 0; n < 2; ++n) acc[a][b][m][n] = (f32x4){0.f, 0.f, 0.f, 0.f};
        cur = nxt; cA = nA; cB = nB; ++ui;
        if constexpr (ALIGN_EPI) { if (wr == 1) PG8_BAR; }
    }
    PG8_WAIT_V(0);
    if constexpr (!ALIGN_EPI) { if (wr == 0) PG8_BAR; }
    PG8_BAR;
    if constexpr (Epi::AFTER_DRAIN) { E.fused(acc, cur, wr, wc, fr, fq, lds, wid, lane); S.done(cur); }
#undef PG8_SA
#undef PG8_SB
#undef PG8_STAGE
#undef PG8_LDA
#undef PG8_LDB
#undef PG8_MMA
#undef PG8_WAIT_V
#undef PG8_WAIT_L
#undef PG8_BAR
#undef PG8_SCHED
}
}
#define GAS __attribute__((address_space(1)))
#define LAS __attribute__((address_space(3)))
typedef unsigned short bf16;
typedef unsigned v4u __attribute__((ext_vector_type(4)));
typedef float f32x4 __attribute__((ext_vector_type(4)));
typedef short bf16x8 __attribute__((ext_vector_type(8)));
typedef GAS unsigned gu32;
typedef GAS unsigned long long gu64;
#define RLX_AGENT __ATOMIC_RELAXED, __HIP_MEMORY_SCOPE_AGENT
#define LDS_WAIT() asm volatile("s_waitcnt lgkmcnt(0)" ::: "memory")
#define VM_WAIT() asm volatile("s_waitcnt vmcnt(0)" ::: "memory")
__device__ __forceinline__ unsigned long long rt() { return __builtin_amdgcn_s_memrealtime(); }
__device__ __forceinline__ unsigned f2bf(float f) { unsigned u = __builtin_bit_cast(unsigned, f); return (u + 0x7fffu + ((u >> 16) & 1u)) >> 16; }
__device__ __forceinline__ unsigned pk2(float lo, float hi) { return f2bf(lo) | (f2bf(hi) << 16); }
#define XB_TMO      128
#define XB_XCNT(j)  (256  + 64 * (j))
#define XB_XSUB(j)  (1280 + 64 * (j))
#define XB_XGEN(j)  (2304 + 64 * (j))
#define XB_TOP      3328
#define XB_TOPGEN   3392
#define XCD_BAR_WORDS 3456
#define XB_SPIN_CAP (1u << 18)

__device__ __forceinline__ unsigned xb_ld(unsigned* p)              { return __hip_atomic_load(p, __ATOMIC_RELAXED, __HIP_MEMORY_SCOPE_AGENT); }
__device__ __forceinline__ unsigned xb_add(unsigned* p, unsigned v) { return __hip_atomic_fetch_add(p, v, __ATOMIC_RELAXED, __HIP_MEMORY_SCOPE_AGENT); }
__device__ __forceinline__ unsigned xb_xcc_id() { return (unsigned)__builtin_amdgcn_s_getreg((3 << 11) | 20) & 0xFu; }
#define XB_SPIN(cond, bar) do { unsigned _sp = 0; while (cond) { __builtin_amdgcn_s_sleep(1); \
    if ((++_sp & 255u) == 0u) { if (xb_ld(&(bar)[XB_TMO])) break; if (_sp > XB_SPIN_CAP) { atomicAdd(&(bar)[XB_TMO], 1u); break; } } } } while (0)

struct XcdBarrier {
    unsigned* bar; unsigned x;
    volatile LAS unsigned* st;
};

__device__ __forceinline__ XcdBarrier xcd_barrier_post(unsigned* bar, volatile LAS unsigned* st) {
    XcdBarrier b; b.bar = bar; b.x = xb_xcc_id(); b.st = st;
    if (threadIdx.x == 0) (void)xb_add(&bar[XB_XCNT(b.x)], 1u);
    return b;
}
__device__ __forceinline__ void xcd_barrier_complete(unsigned* bar, unsigned x, unsigned& nloc, unsigned& nx) {
    const unsigned G = gridDim.x * gridDim.y * gridDim.z;
    unsigned sum, cnt, mine, sp = 0u;
    for (;;) {
        sum = 0u; cnt = 0u; mine = 0u;
#pragma unroll
        for (unsigned j = 0; j < 16; ++j) { const unsigned c = xb_ld(&bar[XB_XCNT(j)]); sum += c; cnt += (c > 0u) ? 1u : 0u; mine = (j == x) ? c : mine; }
        if (sum == G) break;
        __builtin_amdgcn_s_sleep(1);
        if ((++sp & 255u) == 0u) { if (xb_ld(&bar[XB_TMO])) break; if (sp > XB_SPIN_CAP) { atomicAdd(&bar[XB_TMO], 1u); break; } }
    }
    nloc = mine > 0u ? mine : 1u; nx = cnt > 0u ? cnt : 1u;
}

__device__ __forceinline__ void xcd_barrier(const XcdBarrier& b) {
    asm volatile("s_waitcnt vmcnt(0)" ::: "memory");
    __syncthreads();
    if (threadIdx.x == 0) {
        unsigned* bar = b.bar;
        __builtin_amdgcn_s_waitcnt(0);
        unsigned nloc = b.st[0], nx = b.st[1];
        if (nloc == 0u) { xcd_barrier_complete(bar, b.x, nloc, nx); b.st[0] = nloc; b.st[1] = nx; }
        const unsigned old = xb_add(&bar[XB_XSUB(b.x)], 1u);
        const unsigned gen = old / nloc;
        if (old + 1u == (gen + 1u) * nloc) {
            __builtin_amdgcn_fence(__ATOMIC_RELEASE, "agent");
            asm volatile("s_waitcnt vmcnt(0)" ::: "memory");
            const unsigned og = xb_add(&bar[XB_TOP], 1u);
            const unsigned tg = og / nx;
            if (og + 1u == (tg + 1u) * nx) xb_add(&bar[XB_TOPGEN], 1u);
            else XB_SPIN(xb_ld(&bar[XB_TOPGEN]) == tg, bar);
            __builtin_amdgcn_fence(__ATOMIC_ACQUIRE, "agent");
            xb_add(&bar[XB_XGEN(b.x)], 1u);
            asm volatile("s_waitcnt vmcnt(0)" ::: "memory");
        } else {
            XB_SPIN(xb_ld(&bar[XB_XGEN(b.x)]) == gen, bar);
            __builtin_amdgcn_fence(__ATOMIC_ACQUIRE, "agent");
            asm volatile("s_waitcnt vmcnt(0)" ::: "memory");
        }
    }
    __syncthreads();
}

constexpr int NWAVES = 8;
constexpr int BATCH = 8, SEQ = 2048, NMETA = 16, D = 1024;
constexpr int MR = BATCH * SEQ;
constexpr int MT = MR + BATCH * NMETA;
constexpr int M = 16640;
constexpr int INW = 3840, DFF = 2816, NEXP = 8, DEXP = 1408;
constexpr float ALPHA = 1.4142135623730951f;
constexpr float LN_EPS = 1e-5f;

constexpr size_t MiB = 1u << 20;
constexpr size_t WS_CTL = 0, CTL_ZERO_BYTES = 64 * 1024;
constexpr size_t WS_CW = 256 * 1024;
constexpr size_t WS_W = 1 * MiB;
constexpr size_t WS_WIN = WS_W, WS_WAP = WS_W + 15 * MiB / 2, WS_WCP = WS_WAP + MiB, WS_WOUT = WS_WCP + MiB, WS_WGU = WS_WOUT + 2 * MiB, WS_WD = WS_WGU + 44 * MiB;
constexpr size_t AB = 79 * MiB;
constexpr size_t R1024 = (size_t)M * 1024 * 2, R512 = (size_t)M * 512 * 2, R128 = (size_t)M * 128 * 2;
constexpr size_t WS_H = AB, WS_Q = WS_H + R1024, WS_SGA = WS_Q + R512, WS_K = WS_SGA + R1024, WS_V = WS_K + R128, WS_GLU = WS_V + R128, WS_SGC = WS_GLU + R512, WS_CO = WS_SGC + R1024;
constexpr size_t WS_ACT = WS_Q;
constexpr size_t WS_Z = AB + 122 * MiB;
constexpr size_t WS_END = WS_Z + (size_t)M * 1024 * 4;
static_assert(WS_WD + 22 * MiB <= AB && WS_CO + R512 <= WS_END && WS_ACT + (size_t)M * DFF * 2 <= WS_Z && WS_END <= 272 * MiB, "ws map");
constexpr int CW_BAR = 4096;

constexpr int RING_BYTES = 131072, LDSCTL_OFF = RING_BYTES, MISC_OFF = LDSCTL_OFF + 320, LDS_BYTES = 147456;

__device__ __forceinline__ float wave_sum(float v) {
#pragma unroll
    for (int o = 1; o < 64; o <<= 1) v += __shfl_xor(v, o);
    return v;
}
__device__ __forceinline__ float wave_max(float v) {
#pragma unroll
    for (int o = 1; o < 64; o <<= 1) v = fmaxf(v, __shfl_xor(v, o));
    return v;
}
__device__ __forceinline__ float bfl(unsigned w) { return __builtin_bit_cast(float, w << 16); }
__device__ __forceinline__ float bfh(unsigned w) { return __builtin_bit_cast(float, w & 0xffff0000u); }
__device__ __forceinline__ float sigmoid_f(float x) { return 1.0f / (1.0f + __expf(-x)); }

__device__ __forceinline__ int winmap(int n) { return n < 768 ? n : (n < 1280 ? 768 + 2 * (n - 768) : (n < 1792 ? 769 + 2 * (n - 1280) : n)); }
__device__ __forceinline__ void transpose_item(const float* W, int K, int N, bf16* WT, int mode, int roff, LAS float* scr, int item, int lane) {
    const int nblk = N / 32, kb = item / nblk, nb = item % nblk, k0 = 64 * kb, n0 = 32 * nb;
#pragma unroll 8
    for (int i = 0; i < 32; ++i) { const int kk = 2 * i + (lane >> 5); scr[kk * 33 + (lane & 31)] = W[(size_t)(k0 + kk) * N + n0 + (lane & 31)]; }
    LDS_WAIT(); asm volatile("" ::: "memory");
    const int c = lane & 7;
#pragma unroll
    for (int j = 0; j < 4; ++j) { const int n = (lane >> 3) + 8 * j; const LAS float* s = scr + (8 * c) * 33 + n;
        v4u o; o.x = pk2(s[0 * 33], s[1 * 33]); o.y = pk2(s[2 * 33], s[3 * 33]); o.z = pk2(s[4 * 33], s[5 * 33]); o.w = pk2(s[6 * 33], s[7 * 33]);
        const int nn = n0 + n, drow = mode == 0 ? roff + nn : (mode == 1 ? roff + 2 * nn : winmap(nn));
        *(GAS v4u*)(WT + (size_t)drow * K + k0 + 8 * c) = o; }
    LDS_WAIT(); asm volatile("" ::: "memory");
}
struct Args { const float* in[25]; float* out; unsigned char* ws; };
typedef __attribute__((address_space(4))) const Args CArgs;

__device__ __forceinline__ void convert_weights(CArgs* ap, int l, LAS float* scr, int gw, int NGW, int lane_in) {
    int lane = lane_in; asm volatile("" : "+v"(lane));
    unsigned char* ws = ap->ws;
    const int nC = 1920 + 256 + 256 + 512;
    const int total = nC + (l == 0 ? 3 * 1408 : 24 * 704);
    for (int it = gw; it < total; it += NGW) {
        const float* src; bf16* dst; int K, N, mode, roff, li;
        if (it < 1920) { src = ap->in[5] + (size_t)l * 1024 * INW; K = 1024; N = INW; dst = (bf16*)(ws + WS_WIN); mode = 2; roff = 0; li = it; }
        else if (it < 2176) { src = ap->in[11] + (size_t)l * 512 * 1024; K = 512; N = 1024; dst = (bf16*)(ws + WS_WAP); mode = 0; roff = 0; li = it - 1920; }
        else if (it < 2432) { src = ap->in[12] + (size_t)l * 512 * 1024; K = 512; N = 1024; dst = (bf16*)(ws + WS_WCP); mode = 0; roff = 0; li = it - 2176; }
        else if (it < 2944) { src = ap->in[13] + (size_t)l * 1024 * 1024; K = 1024; N = 1024; dst = (bf16*)(ws + WS_WOUT); mode = 0; roff = 0; li = it - 2432; }
        else if (l == 0) { const int r = it - nC, j = r / 1408; li = r % 1408;
            if (j == 0) { src = ap->in[16]; K = 1024; N = DFF; dst = (bf16*)(ws + WS_WGU); mode = 1; roff = 0; }
            else if (j == 1) { src = ap->in[17]; K = 1024; N = DFF; dst = (bf16*)(ws + WS_WGU); mode = 1; roff = 1; }
            else { src = ap->in[18]; K = DFF; N = 1024; dst = (bf16*)(ws + WS_WD); mode = 0; roff = 0; } }
        else { const int r = it - nC, j = r / 704, e = j / 3, kind = j % 3; li = r % 704;
            if (kind == 0) { src = ap->in[20] + (size_t)e * 1024 * DEXP; K = 1024; N = DEXP; dst = (bf16*)(ws + WS_WGU) + (size_t)e * 2 * DEXP * 1024; mode = 1; roff = 0; }
            else if (kind == 1) { src = ap->in[21] + (size_t)e * 1024 * DEXP; K = 1024; N = DEXP; dst = (bf16*)(ws + WS_WGU) + (size_t)e * 2 * DEXP * 1024; mode = 1; roff = 1; }
            else { src = ap->in[22] + (size_t)e * DEXP * 1024; K = DEXP; N = 1024; dst = (bf16*)(ws + WS_WD) + (size_t)e * 1024 * DEXP; mode = 0; roff = 0; } }
        transpose_item(src, K, N, dst, mode, roff, scr, li, lane);
    }
}

__device__ __forceinline__ void ln_row(const float* src, const float* g, const float* b, int lane, f32x4 (&v)[4]) {
    const GAS f32x4* xr = (const GAS f32x4*)src + lane;
    float s = 0.f;
#pragma unroll
    for (int j = 0; j < 4; ++j) { v[j] = xr[64 * j]; s += (v[j].x + v[j].y) + (v[j].z + v[j].w); }
    const float mean = wave_sum(s) * (1.f / 1024.f); float s2 = 0.f;
#pragma unroll
    for (int j = 0; j < 4; ++j) { v[j] = v[j] - mean; s2 += (v[j].x * v[j].x + v[j].y * v[j].y) + (v[j].z * v[j].z + v[j].w * v[j].w); }
    const float rstd = 1.f / sqrtf(wave_sum(s2) * (1.f / 1024.f) + LN_EPS);
#pragma unroll
    for (int j = 0; j < 4; ++j) { const f32x4 gg = ((const GAS f32x4*)g)[lane + 64 * j], bb = ((const GAS f32x4*)b)[lane + 64 * j]; v[j] = v[j] * rstd * gg + bb; }
}
__device__ __forceinline__ void store_row_bf16(bf16* dst, int lane, const f32x4 (&v)[4]) {
    GAS unsigned long long* o8 = (GAS unsigned long long*)dst + lane;
#pragma unroll
    for (int j = 0; j < 4; ++j) o8[64 * j] = (unsigned long long)pk2(v[j].x, v[j].y) | ((unsigned long long)pk2(v[j].z, v[j].w) << 32);
}
__device__ __forceinline__ void embed_phase(CArgs* ap, bf16* H, int gw, int NGW, int lane_in) {
    int lane = lane_in; asm volatile("" : "+v"(lane));
    for (int r = gw; r < M; r += NGW) {
        f32x4 v[4];
        if (r >= MT) {
#pragma unroll
            for (int j = 0; j < 4; ++j) v[j] = (f32x4){0.f, 0.f, 0.f, 0.f};
        } else {
            const float* src = r < MR ? ap->in[0] + (size_t)r * D : ap->in[1] + (size_t)((r - MR) & 15) * D;
            ln_row(src, ap->in[2], ap->in[3], lane, v);
        }
        store_row_bf16(H + (size_t)r * D, lane, v);
    }
}
__device__ __forceinline__ void ln_phase_bf16(const float* Z, const float* g, const float* b, bf16* H, const float* router, float* CW, int gw, int NGW, int lane_in) {
    int lane = lane_in; asm volatile("" : "+v"(lane));
    for (int r = gw; r < M; r += NGW) {
        f32x4 v[4]; ln_row(Z + (size_t)r * D, g, b, lane, v);
        store_row_bf16(H + (size_t)r * D, lane, v);
        if (router) {
            float lg[8];
#pragma unroll
            for (int e = 0; e < 8; ++e) lg[e] = 0.f;
#pragma unroll
            for (int j = 0; j < 4; ++j)
#pragma unroll
                for (int i = 0; i < 4; ++i) { const int col = 256 * j + 4 * lane + i; const f32x4 r0 = *(const GAS f32x4*)(router + (size_t)col * 8), r1 = *(const GAS f32x4*)(router + (size_t)col * 8 + 4); const float x = v[j][i];
                    lg[0] += x * r0.x; lg[1] += x * r0.y; lg[2] += x * r0.z; lg[3] += x * r0.w; lg[4] += x * r1.x; lg[5] += x * r1.y; lg[6] += x * r1.z; lg[7] += x * r1.w; }
#pragma unroll
            for (int e = 0; e < 8; ++e) lg[e] = wave_sum(lg[e]);
            int i1 = 0; float v1 = lg[0];
#pragma unroll
            for (int e = 1; e < 8; ++e) if (lg[e] > v1) { v1 = lg[e]; i1 = e; }
            int i2 = -1; float v2 = -INFINITY;
#pragma unroll
            for (int e = 0; e < 8; ++e) if (e != i1 && lg[e] > v2) { v2 = lg[e]; i2 = e; }
            const float g1 = 1.0f / (1.0f + __expf(v2 - v1)), g2 = 1.0f - g1;
            if (lane < 8) CW[(size_t)lane * M + r] = lane == i1 ? g1 : (lane == i2 ? g2 : 0.f);
        }
    }
}
__device__ __forceinline__ void ln_phase_out(const float* Z, const float* g, const float* b, float* out, int gw, int NGW, int lane_in) {
    int lane = lane_in; asm volatile("" : "+v"(lane));
    for (int r = gw; r < MR; r += NGW) {
        f32x4 v[4]; ln_row(Z + (size_t)r * D, g, b, lane, v);
        GAS f32x4* o = (GAS f32x4*)(out + (size_t)r * D) + lane;
#pragma unroll
        for (int j = 0; j < 4; ++j) o[64 * j] = v[j];
    }
}

__device__ __forceinline__ int rel_bucket(int n) {
    if (n < 16) return n;
    int b = 16; b += n >= 19; b += n >= 21; b += n >= 24; b += n >= 27; b += n >= 31; b += n >= 35; b += n >= 40; b += n >= 46; b += n >= 52; b += n >= 59; b += n >= 67; b += n >= 77; b += n >= 87; b += n >= 99; b += n >= 113;
    return b;
}
__device__ __forceinline__ void attn_naive_phase(const bf16* Q, const bf16* Kb, const bf16* Vb, bf16* AO, const float* rel_bias, const float* sinks, LAS float* pl, int gw, int NGW, int lane_in) {
    int lane = lane_in; asm volatile("" : "+v"(lane));
    for (int it = gw; it < MT * 8; it += NGW) {
        const int row = it >> 3, hq = it & 7, hkv = hq >> 2;
        int b, pos, s, nmeta, band_lo, nband;
        if (row < MR) { b = row >> 11; s = row & 2047; pos = 16 + s; nmeta = 16; band_lo = s - 127 < 0 ? 0 : s - 127; nband = s - band_lo + 1; }
        else { const int mi = row - MR; b = mi >> 4; pos = mi & 15; s = 0; nmeta = pos + 1; band_lo = 0; nband = 0; }
        const int nkeys = nmeta + nband;
        unsigned qw[32];
        { const GAS v4u* qp = (const GAS v4u*)(Q + (size_t)row * 512 + hq * 64);
#pragma unroll
          for (int i = 0; i < 8; ++i) { const v4u t = qp[i]; qw[4 * i] = t.x; qw[4 * i + 1] = t.y; qw[4 * i + 2] = t.z; qw[4 * i + 3] = t.w; } }
        const float sink = sinks[hq];
        float sc[3]; float mx = -INFINITY;
#pragma unroll
        for (int c = 0; c < 3; ++c) {
            const int j = c * 64 + lane; const bool valid = j < nkeys;
            const int jj = valid ? j : 0;
            const int krow = jj < nmeta ? MR + b * 16 + jj : b * 2048 + band_lo + (jj - nmeta);
            const int dist = jj < nmeta ? pos - jj : s - (band_lo + jj - nmeta);
            const GAS v4u* kp = (const GAS v4u*)(Kb + (size_t)krow * 128 + hkv * 64);
            float dot = 0.f;
#pragma unroll
            for (int i = 0; i < 8; ++i) { const v4u t = kp[i];
                dot += bfl(qw[4 * i]) * bfl(t.x) + bfh(qw[4 * i]) * bfh(t.x) + bfl(qw[4 * i + 1]) * bfl(t.y) + bfh(qw[4 * i + 1]) * bfh(t.y)
                     + bfl(qw[4 * i + 2]) * bfl(t.z) + bfh(qw[4 * i + 2]) * bfh(t.z) + bfl(qw[4 * i + 3]) * bfl(t.w) + bfh(qw[4 * i + 3]) * bfh(t.w); }
            sc[c] = valid ? dot * 0.125f + rel_bias[rel_bucket(dist) * 8 + hq] : -INFINITY;
            mx = fmaxf(mx, sc[c]);
        }
        mx = fmaxf(wave_max(mx), sink);
        float ps = 0.f;
#pragma unroll
        for (int c = 0; c < 3; ++c) { const float p = __expf(sc[c] - mx); ps += p; pl[c * 64 + lane] = p; }
        const float denom = wave_sum(ps) + __expf(sink - mx);
        LDS_WAIT(); asm volatile("" ::: "memory");
        float o = 0.f;
#pragma unroll 8
        for (int j = 0; j < nkeys; ++j) {
            const int krow = j < nmeta ? MR + b * 16 + j : b * 2048 + band_lo + (j - nmeta);
            o += pl[j] * bfl((unsigned)Vb[(size_t)krow * 128 + hkv * 64 + lane]);
        }
        LDS_WAIT(); asm volatile("" ::: "memory");
        AO[(size_t)row * 512 + hq * 64 + lane] = (bf16)f2bf(o / denom);
    }
}
__device__ __forceinline__ void conv_naive_phase(const bf16* GLU, bf16* CO, const float* dw, const float* db, const float* lg, const float* lb, int gw, int NGW, int lane_in) {
    int lane = lane_in; asm volatile("" : "+v"(lane));
    for (int row = gw; row < M; row += NGW) {
        if (row >= MT) { *(GAS v4u*)(CO + (size_t)row * 512 + 8 * lane) = (v4u){0u, 0u, 0u, 0u}; continue; }
        int b, pos;
        if (row < MR) { b = row >> 11; pos = 16 + (row & 2047); } else { const int mi = row - MR; b = mi >> 4; pos = mi & 15; }
        float acc[8];
        { const f32x4 b0 = *(const GAS f32x4*)(db + 8 * lane), b1 = *(const GAS f32x4*)(db + 8 * lane + 4); acc[0] = b0.x; acc[1] = b0.y; acc[2] = b0.z; acc[3] = b0.w; acc[4] = b1.x; acc[5] = b1.y; acc[6] = b1.z; acc[7] = b1.w; }
        for (int j = 0; j < 31; ++j) {
            const int p = pos - 30 + j; if (p < 0) continue;
            const int r2 = p < 16 ? MR + b * 16 + p : b * 2048 + p - 16;
            const v4u t = *(const GAS v4u*)(GLU + (size_t)r2 * 512 + 8 * lane);
            const f32x4 w0 = *(const GAS f32x4*)(dw + (size_t)j * 512 + 8 * lane), w1 = *(const GAS f32x4*)(dw + (size_t)j * 512 + 8 * lane + 4);
            acc[0] += bfl(t.x) * w0.x; acc[1] += bfh(t.x) * w0.y; acc[2] += bfl(t.y) * w0.z; acc[3] += bfh(t.y) * w0.w;
            acc[4] += bfl(t.z) * w1.x; acc[5] += bfh(t.z) * w1.y; acc[6] += bfl(t.w) * w1.z; acc[7] += bfh(t.w) * w1.w;
        }
        float s = 0.f;
#pragma unroll
        for (int i = 0; i < 8; ++i) s += acc[i];
        const float mean = wave_sum(s) * (1.f / 512.f); float s2 = 0.f;
#pragma unroll
        for (int i = 0; i < 8; ++i) { acc[i] -= mean; s2 += acc[i] * acc[i]; }
        const float rstd = 1.f / sqrtf(wave_sum(s2) * (1.f / 512.f) + LN_EPS);
        float y[8];
#pragma unroll
        for (int i = 0; i < 8; ++i) { const float t = acc[i] * rstd * lg[8 * lane + i] + lb[8 * lane + i]; y[i] = t * sigmoid_f(t); }
        v4u o; o.x = pk2(y[0], y[1]); o.y = pk2(y[2], y[3]); o.z = pk2(y[4], y[5]); o.w = pk2(y[6], y[7]);
        *(GAS v4u*)(CO + (size_t)row * 512 + 8 * lane) = o;
    }
}

#define HB ((bf16*)(ws + WS_H))
#define QB ((bf16*)(ws + WS_Q))
#define SGA ((bf16*)(ws + WS_SGA))
#define KB ((bf16*)(ws + WS_K))
#define VB ((bf16*)(ws + WS_V))
#define GLU ((bf16*)(ws + WS_GLU))
#define SGC ((bf16*)(ws + WS_SGC))
#define CO ((bf16*)(ws + WS_CO))
#define ACT ((bf16*)(ws + WS_ACT))
#define Z ((float*)(ws + WS_Z))
#define CW ((float*)(ws + WS_CW))
#define Win_t ((bf16*)(ws + WS_WIN))
#define Wap_t ((bf16*)(ws + WS_WAP))
#define Wcp_t ((bf16*)(ws + WS_WCP))
#define Wout_t ((bf16*)(ws + WS_WOUT))
#define Wgu_t ((bf16*)(ws + WS_WGU))
#define Wd_t ((bf16*)(ws + WS_WD))
#define PHASE_CTX() CArgs* ap = (CArgs*)__builtin_amdgcn_kernarg_segment_ptr(); asm volatile("" : "+s"(ap)); unsigned char* ws = ap->ws; \
    int lane = threadIdx.x & 63; asm volatile("" : "+v"(lane)); const int wave = __builtin_amdgcn_readfirstlane(threadIdx.x >> 6); \
    const int G = gridDim.x, gw = blockIdx.x * NWAVES + wave, NGW = G * NWAVES; (void)lane; (void)gw; (void)NGW; (void)ws
#define GRID_BAR() xcd_barrier(bar)
__global__ void __launch_bounds__(NWAVES * 64, 2) fwd_kernel(Args a_unused) {
    extern __shared__ __attribute__((aligned(16))) unsigned char lds[];
    LAS unsigned char* L = (LAS unsigned char*)lds;
    XcdBarrier bar;
    { PHASE_CTX();
      for (int u = threadIdx.x; u < (LDS_BYTES - LDSCTL_OFF) / 4; u += NWAVES * 64) ((LAS unsigned*)(L + LDSCTL_OFF))[u] = 0u;
      __syncthreads();
      bar = xcd_barrier_post((unsigned*)(ws + WS_CTL) + CW_BAR, (volatile LAS unsigned*)(L + MISC_OFF) + 8);
      convert_weights(ap, 0, (LAS float*)(L + wave * 16384), gw, NGW, lane);
      embed_phase(ap, HB, gw, NGW, lane); }
    GRID_BAR();

    for (int l = 0; l < 2; ++l) {
        { PHASE_CTX(); pg8::Gemm g{HB, Win_t, M, INW, 1024}; pg8::StaticOrder S; S.init(M, INW, G, (int)blockIdx.x);
          pg8::EpiWin E{QB, KB, VB, GLU, SGA, SGC};
          pg8::gemm_phase<pg8::EpiWin, pg8::StaticOrder, true, true>(L, g, S, E); }
        GRID_BAR();
        { PHASE_CTX(); attn_naive_phase(QB, KB, VB, QB, ap->in[4], ap->in[10] + l * 8, (LAS float*)(L + wave * 1024), gw, NGW, lane); }
        { PHASE_CTX(); conv_naive_phase(GLU, CO, ap->in[6] + (size_t)l * 31 * 512, ap->in[7] + l * 512, ap->in[8] + l * 512, ap->in[9] + l * 512, gw, NGW, lane); }
        GRID_BAR();
        for (int pass = 0; pass < 2; ++pass) {
            { PHASE_CTX(); pg8::Gemm g{pass ? CO : QB, pass ? Wcp_t : Wap_t, M, 1024, 512}; pg8::StaticOrder S; S.init(M, 1024, G, (int)blockIdx.x);
              pg8::EpiGate E{SGA, pass ? SGC : SGA, pass};
              pg8::gemm_phase<pg8::EpiGate, pg8::StaticOrder, true, true>(L, g, S, E); }
            GRID_BAR();
        }
        { PHASE_CTX(); pg8::Gemm g{SGA, Wout_t, M, 1024, 1024}; pg8::StaticOrder S; S.init(M, 1024, G, (int)blockIdx.x);
          pg8::EpiResF32 E{Z, HB, nullptr, 0, ALPHA};
          pg8::gemm_phase<pg8::EpiResF32, pg8::StaticOrder, true, true>(L, g, S, E); }
        GRID_BAR();
        { PHASE_CTX(); ln_phase_bf16(Z, ap->in[14] + l * D, ap->in[15] + l * D, HB, l == 1 ? ap->in[19] : nullptr, CW, gw, NGW, lane); }
        GRID_BAR();
        if (l == 0) {
            { PHASE_CTX(); pg8::Gemm g{HB, Wgu_t, M, 2 * DFF, 1024}; pg8::StaticOrder S; S.init(M, 2 * DFF, G, (int)blockIdx.x);
              pg8::EpiSwiGLU E{ACT, DFF};
              pg8::gemm_phase<pg8::EpiSwiGLU, pg8::StaticOrder, true, true>(L, g, S, E); }
            GRID_BAR();
            { PHASE_CTX(); pg8::Gemm g{ACT, Wd_t, M, 1024, DFF}; pg8::StaticOrder S; S.init(M, 1024, G, (int)blockIdx.x);
              pg8::EpiResF32 E{Z, HB, nullptr, 0, ALPHA};
              pg8::gemm_phase<pg8::EpiResF32, pg8::StaticOrder, true, true>(L, g, S, E); }
            GRID_BAR();
            { PHASE_CTX(); ln_phase_bf16(Z, ap->in[23], ap->in[24], HB, nullptr, nullptr, gw, NGW, lane); }
            { PHASE_CTX(); convert_weights(ap, 1, (LAS float*)(L + wave * 16384), gw, NGW, lane); }
            GRID_BAR();
        } else {
            for (int e = 0; e < NEXP; ++e) {
                { PHASE_CTX(); pg8::Gemm g{HB, Wgu_t + (size_t)e * 2 * DEXP * 1024, M, 2 * DEXP, 1024}; pg8::StaticOrder S; S.init(M, 2 * DEXP, G, (int)blockIdx.x);
                  pg8::EpiSwiGLU E{ACT, DEXP};
                  pg8::gemm_phase<pg8::EpiSwiGLU, pg8::StaticOrder, true, true>(L, g, S, E); }
                GRID_BAR();
                { PHASE_CTX(); pg8::Gemm g{ACT, Wd_t + (size_t)e * 1024 * DEXP, M, 1024, DEXP}; pg8::StaticOrder S; S.init(M, 1024, G, (int)blockIdx.x);
                  pg8::EpiResF32 E{Z, HB, CW + (size_t)e * M, e == 0 ? 1 : 2, ALPHA};
                  pg8::gemm_phase<pg8::EpiResF32, pg8::StaticOrder, true, true>(L, g, S, E); }
                GRID_BAR();
            }
            { PHASE_CTX(); ln_phase_out(Z, ap->in[23] + D, ap->in[24] + D, ap->out, gw, NGW, lane); }
        }
    }
}

extern "C" void kernel_launch(void* const* d_in, const int* in_sizes, int n_in, void* d_out, int out_size, void* d_ws, size_t ws_size, hipStream_t stream) {
    static int grid = 0;
    if (grid == 0) {
        if (n_in != 25 || out_size != MR * D || ws_size < WS_END) { fprintf(stderr, "kernel_launch: unexpected shapes (n_in %d, out %d, ws %zu, need %zu)\n", n_in, out_size, ws_size, (size_t)WS_END); grid = -1; return; }
        int dev = 0, cus = 0, per_cu = 0;
        if (hipGetDevice(&dev) != hipSuccess || hipDeviceGetAttribute(&cus, hipDeviceAttributeMultiprocessorCount, dev) != hipSuccess) { grid = -1; return; }
        if (hipFuncSetAttribute((const void*)fwd_kernel, hipFuncAttributeMaxDynamicSharedMemorySize, LDS_BYTES) != hipSuccess) { fprintf(stderr, "kernel_launch: hipFuncSetAttribute failed\n"); grid = -1; return; }
        if (hipOccupancyMaxActiveBlocksPerMultiprocessor(&per_cu, (const void*)fwd_kernel, NWAVES * 64, LDS_BYTES) != hipSuccess || per_cu < 1) { fprintf(stderr, "kernel_launch: occupancy query says %d blocks per CU\n", per_cu); grid = -1; (void)hipGetLastError(); return; }
        (void)hipGetLastError();
        grid = cus;
    }
    if (grid < 0) return;
    if (hipMemsetAsync((char*)d_ws + WS_CTL, 0, CTL_ZERO_BYTES, stream) != hipSuccess) return;
    Args a{};
    for (int i = 0; i < 25; ++i) a.in[i] = (const float*)d_in[i];
    a.out = (float*)d_out; a.ws = (unsigned char*)d_ws;
    hipLaunchKernelGGL(fwd_kernel, dim3(grid), dim3(NWAVES * 64), LDS_BYTES, stream, a);
}
```

```cpp
#include <hip/hip_runtime.h>
#include <cstdio>
#include <cstdint>
#include <cmath>
namespace pg8 {
#define PG8_LAS __attribute__((address_space(3)))
typedef unsigned short bf16_t;
typedef short bf16x8 __attribute__((ext_vector_type(8)));
typedef float f32x4 __attribute__((ext_vector_type(4)));
typedef unsigned u32x4 __attribute__((ext_vector_type(4)));
constexpr int BM = 256, BK = 64, HALF = 128, HTB = HALF * BK * 2  , STAGE_BYTES = 8 * HTB, NXCD = 8, WGM = 8;

__host__ __device__ __forceinline__ int lds_byte(int r, int c) { const int st = (r >> 4) * 2 + (c >> 5), rr = r & 15, cc = c & 31, ob = rr * 64 + cc * 2; return st * 1024 + (ob ^ (((ob >> 9) & 1) << 5)); }
__host__ __device__ __forceinline__ void stage_rc(int b, int& R, int& C) { const int st = b / 1024, sb = b % 1024, swz = sb ^ (((sb >> 9) & 1) << 5); R = (st >> 1) * 16 + swz / 64; C = (st & 1) * 32 + (swz % 64) / 2; }
__host__ __device__ __forceinline__ int perm32(int rho) { const int n = rho >> 4, i = rho & 15; return 8 * (i >> 2) + 4 * n + (i & 3); }

struct Unit { int pm, pn; };
struct Gemm { const bf16_t* A; const bf16_t* Bt; int M, N, K; };

struct StaticOrder {
    int nM, nN, nwg, G, c;
    __host__ __device__ void init(int M, int N, int G_, int c_) { nM = M / BM; nN = N / BM; nwg = nM * nN; G = G_; c = c_; }
    __host__ __device__ bool next(int i, Unit& u) const {
        const long L = (long)i * G + c; if (L >= nwg) return false;
        int wgid = (int)L; { const int q = nwg / NXCD, r = nwg % NXCD, xcd = wgid % NXCD, off = wgid / NXCD; wgid = (xcd < r ? xcd * (q + 1) : r * (q + 1) + (xcd - r) * q) + off; }
        const int nig = WGM * nN, gid = wgid / nig, fm = gid * WGM, gsz = (nM - fm) < WGM ? (nM - fm) : WGM;
        u.pm = fm + ((wgid % nig) % gsz); u.pn = (wgid % nig) / gsz; return true;
    }
    __device__ __forceinline__ void a_ready(const Unit&) const {}
    __device__ __forceinline__ void done(const Unit&) const {}
};

__device__ __forceinline__ unsigned cvt_pk_bf16(float lo, float hi) { unsigned r; asm volatile("v_cvt_pk_bf16_f32 %0, %1, %2" : "=v"(r) : "v"(lo), "v"(hi)); return r; }
typedef float f32x2 __attribute__((ext_vector_type(2)));
typedef unsigned u32x2 __attribute__((ext_vector_type(2)));
__device__ __forceinline__ float bf_lo(unsigned w) { return __builtin_bit_cast(float, w << 16); }
__device__ __forceinline__ float bf_hi(unsigned w) { return __builtin_bit_cast(float, w & 0xffff0000u); }
__device__ __forceinline__ float sigm(float x) { return __builtin_amdgcn_rcpf(1.0f + __builtin_amdgcn_exp2f(-1.4426950408889634f * x)); }
__device__ __forceinline__ u32x4 pack8(const f32x4 a, const f32x4 b) { u32x4 w; w.x = cvt_pk_bf16(a[0], a[1]); w.y = cvt_pk_bf16(a[2], a[3]); w.z = cvt_pk_bf16(b[0], b[1]); w.w = cvt_pk_bf16(b[2], b[3]); return w; }
__device__ __forceinline__ void unpack8(const u32x4 w, f32x4& a, f32x4& b) { a = (f32x4){bf_lo(w.x), bf_hi(w.x), bf_lo(w.y), bf_hi(w.y)}; b = (f32x4){bf_lo(w.z), bf_hi(w.z), bf_lo(w.w), bf_hi(w.w)}; }

struct EpiWin {
    static constexpr bool PERM = true, AFTER_DRAIN = false;
    bf16_t *Q, *Kb, *Vb, *GLU, *SGA, *SGC;
    __device__ __forceinline__ void operator()(const f32x4 (&acc)[2][2][4][2], const Unit& u, int wr, int wc, int fr, int fq) const {
        const int row0 = u.pm * BM + wr * 64 + fr, pn = u.pn, cin = wc * 32 + 8 * fq;
#pragma unroll
        for (int ai = 0; ai < 2; ++ai)
#pragma unroll
            for (int m = 0; m < 4; ++m) { const size_t row = (size_t)(row0 + ai * HALF + m * 16);
#pragma unroll
                for (int bj = 0; bj < 2; ++bj) { const f32x4 v0 = acc[ai][bj][m][0], v1 = acc[ai][bj][m][1];
                    if (pn < 2) { *(u32x4*)(Q + row * 512 + pn * 256 + bj * HALF + cin) = pack8(v0, v1); }
                    else if (pn == 2) { bf16_t* base = bj ? Vb : Kb; *(u32x4*)(base + row * 128 + cin) = pack8(v0, v1); }
                    else if (pn < 7) { u32x2 w; w.x = cvt_pk_bf16(v0[0] * sigm(v0[1]), v0[2] * sigm(v0[3])); w.y = cvt_pk_bf16(v1[0] * sigm(v1[1]), v1[2] * sigm(v1[3]));
                        *(u32x2*)(GLU + row * 512 + (pn - 3) * 128 + bj * 64 + (cin >> 1)) = w; }
                    else { const f32x4 s0 = (f32x4){sigm(v0[0]), sigm(v0[1]), sigm(v0[2]), sigm(v0[3])}, s1 = (f32x4){sigm(v1[0]), sigm(v1[1]), sigm(v1[2]), sigm(v1[3])};
                        bf16_t* base = pn < 11 ? SGA + (pn - 7) * 256 : SGC + (pn - 11) * 256; *(u32x4*)(base + row * 1024 + bj * HALF + cin) = pack8(s0, s1); } } }
    }
};
struct EpiGate {
    static constexpr bool PERM = true, AFTER_DRAIN = false;
    bf16_t* G; const bf16_t* S; int add;
    __device__ __forceinline__ void operator()(const f32x4 (&acc)[2][2][4][2], const Unit& u, int wr, int wc, int fr, int fq) const {
        const int row0 = u.pm * BM + wr * 64 + fr, col0 = u.pn * BM + wc * 32 + 8 * fq;
#pragma unroll
        for (int ai = 0; ai < 2; ++ai)
#pragma unroll
            for (int m = 0; m < 4; ++m) { const size_t off = (size_t)(row0 + ai * HALF + m * 16) * 1024 + col0;
#pragma unroll
                for (int bj = 0; bj < 2; ++bj) { f32x4 s0, s1; unpack8(*(const u32x4*)(S + off + bj * HALF), s0, s1);
                    f32x4 o0 = s0 * acc[ai][bj][m][0], o1 = s1 * acc[ai][bj][m][1];
                    if (add) { f32x4 g0, g1; unpack8(*(const u32x4*)(G + off + bj * HALF), g0, g1); o0 += g0; o1 += g1; }
                    *(u32x4*)(G + off + bj * HALF) = pack8(o0, o1); }
                asm volatile("" ::: "memory"); }
    }
};
struct EpiResF32 {
    static constexpr bool PERM = false, AFTER_DRAIN = false;
    float* Z; const bf16_t* H; const float* cw; int mode; float alpha;
    __device__ __forceinline__ void operator()(const f32x4 (&acc)[2][2][4][2], const Unit& u, int wr, int wc, int fr, int fq) const {
        const int row0 = u.pm * BM + wr * 64 + fr, col0 = u.pn * BM + wc * 32 + 4 * fq;
#pragma unroll
        for (int ai = 0; ai < 2; ++ai)
#pragma unroll
            for (int m = 0; m < 4; ++m) { const int row = row0 + ai * HALF + m * 16; const size_t off = (size_t)row * 1024 + col0;
                const float c = mode ? cw[row] : 1.0f;
#pragma unroll
                for (int bj = 0; bj < 2; ++bj)
#pragma unroll
                    for (int n = 0; n < 2; ++n) { const size_t o = off + bj * HALF + n * 16; f32x4 base;
                        if (mode == 2) base = *(const f32x4*)(Z + o);
                        else { const u32x2 hw = *(const u32x2*)(H + o); base = (f32x4){bf_lo(hw.x), bf_hi(hw.x), bf_lo(hw.y), bf_hi(hw.y)} * alpha; }
                        *(f32x4*)(Z + o) = base + acc[ai][bj][m][n] * c; }
                asm volatile("" ::: "memory"); }
    }
};
struct EpiSwiGLU {
    static constexpr bool PERM = true, AFTER_DRAIN = false;
    bf16_t* O; int ldc;
    __device__ __forceinline__ void operator()(const f32x4 (&acc)[2][2][4][2], const Unit& u, int wr, int wc, int fr, int fq) const {
        const int row0 = u.pm * BM + wr * 64 + fr, col0 = (u.pn * BM + wc * 32 + 8 * fq) >> 1;
#pragma unroll
        for (int ai = 0; ai < 2; ++ai)
#pragma unroll
            for (int m = 0; m < 4; ++m) { bf16_t* rowp = O + (size_t)(row0 + ai * HALF + m * 16) * ldc + col0;
#pragma unroll
                for (int bj = 0; bj < 2; ++bj) { const f32x4 v0 = acc[ai][bj][m][0], v1 = acc[ai][bj][m][1]; u32x2 w;
                    w.x = cvt_pk_bf16(v0[0] * sigm(v0[0]) * v0[1], v0[2] * sigm(v0[2]) * v0[3]); w.y = cvt_pk_bf16(v1[0] * sigm(v1[0]) * v1[1], v1[2] * sigm(v1[2]) * v1[3]);
                    *(u32x2*)(rowp + bj * 64) = w; } }
    }
};

template <class Epi, class Sched, bool ALIGN_EPI = false, bool SP2 = false>
__device__ __forceinline__ void gemm_phase(PG8_LAS unsigned char* lds, const Gemm g, const Sched& S, const Epi& E) {
    int tid_ = threadIdx.x; asm volatile("" : "+v"(tid_));
    const int tid = tid_, wid = __builtin_amdgcn_readfirstlane(tid >> 6), lane = tid & 63, wr = wid >> 2, wc = wid & 3, fr = lane & 15, fq = lane >> 4;
    const int K = g.K, nt = K / BK;
    unsigned voffA[2], voffB[2];
#pragma unroll
    for (int i = 0; i < 2; ++i) { int R, C; stage_rc(tid * 16 + i * 8192, R, C); const int Rb = Epi::PERM ? ((R & ~31) + perm32(R & 31)) : R;
        voffA[i] = (unsigned)(R * K + C) * 2u; voffB[i] = (unsigned)(Rb * K + C) * 2u; }
    const size_t kstep = (size_t)(BK * 2);
    const size_t hstep = (size_t)HALF * K * 2;
    const size_t tstep = 2 * hstep;
    const unsigned ldsw = (unsigned)wid * 1024u;
    const int aoff = lds_byte(wr * 64 + fr, fq * 8), boff = lds_byte(wc * 32 + fr, fq * 8);
#define PG8_SA(b, h) (((b) * 2 + (h)) * HTB)
#define PG8_SB(b, h) ((4 + (b) * 2 + (h)) * HTB)
#define PG8_STAGE(bufoff, gbase, voff) do { _Pragma("unroll") for (int _i = 0; _i < 2; ++_i) \
        __builtin_amdgcn_global_load_lds((const unsigned*)((const char*)(gbase) + (voff)[_i]), (PG8_LAS unsigned*)(lds + (bufoff) + ldsw + _i * 8192), 16, 0, 0); } while (0)
#define PG8_LDA(dst, b, h) do { _Pragma("unroll") for (int m = 0; m < 4; ++m) _Pragma("unroll") for (int k = 0; k < 2; ++k) dst[m][k] = *(const PG8_LAS bf16x8*)(lds + PG8_SA(b, h) + aoff + m * 2048 + k * 1024); } while (0)
#define PG8_LDB(dst, b, h) do { _Pragma("unroll") for (int n = 0; n < 2; ++n) _Pragma("unroll") for (int k = 0; k < 2; ++k) dst[n][k] = *(const PG8_LAS bf16x8*)(lds + PG8_SB(b, h) + boff + n * 2048 + k * 1024); } while (0)
#define PG8_MMA(ai, bj, At, Bt) do { __builtin_amdgcn_s_setprio(1); _Pragma("unroll") for (int m = 0; m < 4; ++m) _Pragma("unroll") for (int n = 0; n < 2; ++n) _Pragma("unroll") for (int k = 0; k < 2; ++k) \
        acc[ai][bj][m][n] = __builtin_amdgcn_mfma_f32_16x16x32_bf16(Bt[n][k], At[m][k], acc[ai][bj][m][n], 0, 0, 0); __builtin_amdgcn_s_setprio(0); } while (0)
#define PG8_WAIT_V(n) asm volatile("s_waitcnt vmcnt(" #n ")" ::: "memory")
#define PG8_WAIT_L(n) asm volatile("s_waitcnt lgkmcnt(" #n ")" ::: "memory")
#define PG8_BAR __builtin_amdgcn_s_barrier()
#define PG8_SCHED __builtin_amdgcn_sched_barrier(0)
    Unit cur, nxt; int ui = 0;
    if (!S.next(0, cur)) return;
    f32x4 acc[2][2][4][2];
#pragma unroll
    for (int a = 0; a < 2; ++a)
#pragma unroll
        for (int b = 0; b < 2; ++b)
#pragma unroll
            for (int m = 0; m < 4; ++m)
#pragma unroll
                for (int n = 0; n < 2; ++n) acc[a][b][m][n] = (f32x4){0.f, 0.f, 0.f, 0.f};
    bf16x8 At[4][2], B0[2][2], B1[2][2];
    const char* cA = (const char*)g.A + (size_t)cur.pm * tstep; const char* cB = (const char*)g.Bt + (size_t)cur.pn * tstep;
    S.a_ready(cur);
    if constexpr (SP2) {
        PG8_STAGE(PG8_SB(0, 0), cB, voffB); PG8_STAGE(PG8_SB(0, 1), cB + hstep, voffB); PG8_STAGE(PG8_SA(0, 0), cA, voffA); PG8_STAGE(PG8_SA(0, 1), cA + hstep, voffA);
        if (wr == 1) PG8_BAR;
        PG8_WAIT_V(2); PG8_BAR;
        PG8_STAGE(PG8_SB(1, 0), cB + kstep, voffB); PG8_STAGE(PG8_SA(1, 0), cA + kstep, voffA); PG8_STAGE(PG8_SB(1, 1), cB + hstep + kstep, voffB);
        PG8_WAIT_V(6); PG8_BAR;
    } else {
        PG8_STAGE(PG8_SB(0, 0), cB, voffB); PG8_STAGE(PG8_SA(0, 0), cA, voffA); PG8_STAGE(PG8_SB(0, 1), cB + hstep, voffB); PG8_STAGE(PG8_SA(0, 1), cA + hstep, voffA);
        if (wr == 1) PG8_BAR;
        PG8_WAIT_V(4); PG8_BAR;
        PG8_STAGE(PG8_SB(1, 0), cB + kstep, voffB); PG8_STAGE(PG8_SA(1, 0), cA + kstep, voffA); PG8_STAGE(PG8_SB(1, 1), cB + hstep + kstep, voffB);
        PG8_WAIT_V(6); PG8_BAR;
    }
    for (;;) {
        const bool has_next = S.next(ui + 1, nxt);
        const char* nA = has_next ? (const char*)g.A + (size_t)nxt.pm * tstep : cA; const char* nB = has_next ? (const char*)g.Bt + (size_t)nxt.pn * tstep : cB;
        for (int t = 0; t < nt; t += 2) {
            const bool last = (t == nt - 2);
            const char* a1 = cA + (size_t)(t + 1) * kstep;
            const char* a2 = last ? nA : cA + (size_t)(t + 2) * kstep; const char* b2 = last ? nB : cB + (size_t)(t + 2) * kstep;
            const char* a3 = a2 + kstep; const char* b3 = b2 + kstep;
            if (last && has_next) S.a_ready(nxt);
            if constexpr (SP2) {
            PG8_LDB(B0, 0, 0); PG8_LDB(B1, 0, 1); PG8_SCHED; PG8_LDA(At, 0, 0); PG8_STAGE(PG8_SA(1, 1), a1 + hstep, voffA);
            PG8_WAIT_V(8); PG8_WAIT_L(0); PG8_BAR; PG8_MMA(0, 0, At, B0); PG8_MMA(0, 1, At, B1); PG8_BAR; PG8_SCHED;
            PG8_LDA(At, 0, 1); PG8_STAGE(PG8_SB(0, 0), b2, voffB); PG8_STAGE(PG8_SB(0, 1), b2 + hstep, voffB); PG8_STAGE(PG8_SA(0, 0), a2, voffA);
            PG8_WAIT_V(8); PG8_WAIT_L(0); PG8_BAR; PG8_MMA(1, 0, At, B0); PG8_MMA(1, 1, At, B1); PG8_BAR; PG8_SCHED;
            PG8_LDB(B0, 1, 0); PG8_LDB(B1, 1, 1); PG8_SCHED; PG8_LDA(At, 1, 0); PG8_STAGE(PG8_SA(0, 1), a2 + hstep, voffA);
            PG8_WAIT_V(8); PG8_WAIT_L(0); PG8_BAR; PG8_MMA(0, 0, At, B0); PG8_MMA(0, 1, At, B1); PG8_BAR; PG8_SCHED;
            PG8_LDA(At, 1, 1); PG8_STAGE(PG8_SB(1, 0), b3, voffB); PG8_STAGE(PG8_SB(1, 1), b3 + hstep, voffB); PG8_STAGE(PG8_SA(1, 0), a3, voffA);
            PG8_WAIT_V(8); PG8_WAIT_L(0); PG8_BAR; PG8_MMA(1, 0, At, B0); PG8_MMA(1, 1, At, B1); PG8_BAR; PG8_SCHED;
            } else {
            PG8_LDB(B0, 0, 0); PG8_SCHED; PG8_LDA(At, 0, 0); PG8_STAGE(PG8_SA(1, 1), a1 + hstep, voffA);
            PG8_WAIT_L(8); PG8_BAR; PG8_WAIT_L(0); PG8_MMA(0, 0, At, B0); PG8_BAR; PG8_SCHED;
            PG8_LDB(B1, 0, 1); PG8_STAGE(PG8_SB(0, 0), b2, voffB);
            PG8_BAR; PG8_WAIT_L(0); PG8_MMA(0, 1, At, B1); PG8_BAR;
            PG8_LDA(At, 0, 1); PG8_STAGE(PG8_SA(0, 0), a2, voffA);
            PG8_BAR; PG8_WAIT_L(0); PG8_MMA(1, 0, At, B0); PG8_BAR; PG8_SCHED;
            PG8_STAGE(PG8_SB(0, 1), b2 + hstep, voffB);
            PG8_WAIT_V(6); PG8_BAR; PG8_MMA(1, 1, At, B1); PG8_BAR;
            PG8_LDB(B0, 1, 0); PG8_SCHED; PG8_LDA(At, 1, 0); PG8_STAGE(PG8_SA(0, 1), a2 + hstep, voffA);
            PG8_WAIT_L(8); PG8_BAR; PG8_WAIT_L(0); PG8_MMA(0, 0, At, B0); PG8_BAR; PG8_SCHED;
            PG8_LDB(B1, 1, 1); PG8_STAGE(PG8_SB(1, 0), b3, voffB);
            PG8_BAR; PG8_WAIT_L(0); PG8_MMA(0, 1, At, B1); PG8_BAR;
            PG8_LDA(At, 1, 1); PG8_STAGE(PG8_SA(1, 0), a3, voffA);
            PG8_BAR; PG8_WAIT_L(0); PG8_MMA(1, 0, At, B0); PG8_BAR; PG8_SCHED;
            PG8_STAGE(PG8_SB(1, 1), b3 + hstep, voffB);
            PG8_WAIT_V(6); PG8_BAR; PG8_MMA(1, 1, At, B1); PG8_BAR;
            }
        }
        if constexpr (ALIGN_EPI) { if (wr == 0) PG8_BAR; }
        if constexpr (!Epi::AFTER_DRAIN) { E(acc, cur, wr, wc, fr, fq); S.done(cur); }
        if (!has_next) break;
#pragma unroll
        for (int a = 0; a < 2; ++a)
#pragma unroll
            for (int b = 0; b < 2; ++b)
#pragma unroll
                for (int m = 0; m < 4; ++m)
#pragma unroll
                    for (int n = 0; n < 2; ++n) acc[a][b][m][n] = (f32x4){0.f, 0.f, 0.f, 0.f};
        cur = nxt; cA = nA; cB = nB; ++ui;
        if constexpr (ALIGN_EPI) { if (wr == 1) PG8_BAR; }
    }
    PG8_WAIT_V(0);
    if constexpr (!ALIGN_EPI) { if (wr == 0) PG8_BAR; }
    PG8_BAR;
    if constexpr (Epi::AFTER_DRAIN) { E.fused(acc, cur, wr, wc, fr, fq, lds, wid, lane); S.done(cur); }
#undef PG8_SA
#undef PG8_SB
#undef PG8_STAGE
#undef PG8_LDA
#undef PG8_LDB
#undef PG8_MMA
#undef PG8_WAIT_V
#undef PG8_WAIT_L
#undef PG8_BAR
#undef PG8_SCHED
}
}
#define GAS __attribute__((address_space(1)))
#define LAS __attribute__((address_space(3)))
typedef unsigned short bf16;
typedef unsigned v4u __attribute__((ext_vector_type(4)));
typedef float f32x4 __attribute__((ext_vector_type(4)));
typedef short bf16x8 __attribute__((ext_vector_type(8)));
typedef GAS unsigned gu32;
typedef GAS unsigned long long gu64;
#define RLX_AGENT __ATOMIC_RELAXED, __HIP_MEMORY_SCOPE_AGENT
#define LDS_WAIT() asm volatile("s_waitcnt lgkmcnt(0)" ::: "memory")
#define VM_WAIT() asm volatile("s_waitcnt vmcnt(0)" ::: "memory")
__device__ __forceinline__ unsigned long long rt() { return __builtin_amdgcn_s_memrealtime(); }
__device__ __forceinline__ unsigned f2bf(float f) { unsigned u = __builtin_bit_cast(unsigned, f); return (u + 0x7fffu + ((u >> 16) & 1u)) >> 16; }
__device__ __forceinline__ unsigned pk2(float lo, float hi) { return f2bf(lo) | (f2bf(hi) << 16); }
#define XB_TMO      128
#define XB_XCNT(j)  (256  + 64 * (j))
#define XB_XSUB(j)  (1280 + 64 * (j))
#define XB_XGEN(j)  (2304 + 64 * (j))
#define XB_TOP      3328
#define XB_TOPGEN   3392
#define XCD_BAR_WORDS 3456
#define XB_SPIN_CAP (1u << 18)

__device__ __forceinline__ unsigned xb_ld(unsigned* p)              { return __hip_atomic_load(p, __ATOMIC_RELAXED, __HIP_MEMORY_SCOPE_AGENT); }
__device__ __forceinline__ unsigned xb_add(unsigned* p, unsigned v) { return __hip_atomic_fetch_add(p, v, __ATOMIC_RELAXED, __HIP_MEMORY_SCOPE_AGENT); }
__device__ __forceinline__ unsigned xb_xcc_id() { return (unsigned)__builtin_amdgcn_s_getreg((3 << 11) | 20) & 0xFu; }
#define XB_SPIN(cond, bar) do { unsigned _sp = 0; while (cond) { __builtin_amdgcn_s_sleep(1); \
    if ((++_sp & 255u) == 0u) { if (xb_ld(&(bar)[XB_TMO])) break; if (_sp > XB_SPIN_CAP) { atomicAdd(&(bar)[XB_TMO], 1u); break; } } } } while (0)

struct XcdBarrier {
    unsigned* bar; unsigned x;
    volatile LAS unsigned* st;
};

__device__ __forceinline__ XcdBarrier xcd_barrier_post(unsigned* bar, volatile LAS unsigned* st) {
    XcdBarrier b; b.bar = bar; b.x = xb_xcc_id(); b.st = st;
    if (threadIdx.x == 0) (void)xb_add(&bar[XB_XCNT(b.x)], 1u);
    return b;
}
__device__ __forceinline__ void xcd_barrier_complete(unsigned* bar, unsigned x, unsigned& nloc, unsigned& nx) {
    const unsigned G = gridDim.x * gridDim.y * gridDim.z;
    unsigned sum, cnt, mine, sp = 0u;
    for (;;) {
        sum = 0u; cnt = 0u; mine = 0u;
#pragma unroll
        for (unsigned j = 0; j < 16; ++j) { const unsigned c = xb_ld(&bar[XB_XCNT(j)]); sum += c; cnt += (c > 0u) ? 1u : 0u; mine = (j == x) ? c : mine; }
        if (sum == G) break;
        __builtin_amdgcn_s_sleep(1);
        if ((++sp & 255u) == 0u) { if (xb_ld(&bar[XB_TMO])) break; if (sp > XB_SPIN_CAP) { atomicAdd(&bar[XB_TMO], 1u); break; } }
    }
    nloc = mine > 0u ? mine : 1u; nx = cnt > 0u ? cnt : 1u;
}

__device__ __forceinline__ void xcd_barrier(const XcdBarrier& b) {
    asm volatile("s_waitcnt vmcnt(0)" ::: "memory");
    __syncthreads();
    if (threadIdx.x == 0) {
        unsigned* bar = b.bar;
        __builtin_amdgcn_s_waitcnt(0);
        unsigned nloc = b.st[0], nx = b.st[1];
        if (nloc == 0u) { xcd_barrier_complete(bar, b.x, nloc, nx); b.st[0] = nloc; b.st[1] = nx; }
        const unsigned old = xb_add(&bar[XB_XSUB(b.x)], 1u);
        const unsigned gen = old / nloc;
        if (old + 1u == (gen + 1u) * nloc) {
            __builtin_amdgcn_fence(__ATOMIC_RELEASE, "agent");
            asm volatile("s_waitcnt vmcnt(0)" ::: "memory");
            const unsigned og = xb_add(&bar[XB_TOP], 1u);
            const unsigned tg = og / nx;
            if (og + 1u == (tg + 1u) * nx) xb_add(&bar[XB_TOPGEN], 1u);
            else XB_SPIN(xb_ld(&bar[XB_TOPGEN]) == tg, bar);
            __builtin_amdgcn_fence(__ATOMIC_ACQUIRE, "agent");
            xb_add(&bar[XB_XGEN(b.x)], 1u);
            asm volatile("s_waitcnt vmcnt(0)" ::: "memory");
        } else {
            XB_SPIN(xb_ld(&bar[XB_XGEN(b.x)]) == gen, bar);
            __builtin_amdgcn_fence(__ATOMIC_ACQUIRE, "agent");
            asm volatile("s_waitcnt vmcnt(0)" ::: "memory");
        }
    }
    __syncthreads();
}

constexpr int NWAVES = 8;
constexpr int BATCH = 8, SEQ = 2048, NMETA = 16, D = 1024;
constexpr int MR = BATCH * SEQ;
constexpr int MT = MR + BATCH * NMETA;
constexpr int M = 16640;
constexpr int INW = 3840, DFF = 2816, NEXP = 8, DEXP = 1408;
constexpr float ALPHA = 1.4142135623730951f;
constexpr float LN_EPS = 1e-5f;

constexpr size_t MiB = 1u << 20;
constexpr size_t WS_CTL = 0, CTL_ZERO_BYTES = 64 * 1024;
constexpr size_t WS_CW = 256 * 1024;
constexpr size_t WS_W = 1 * MiB;
constexpr size_t WS_WIN = WS_W, WS_WAP = WS_W + 15 * MiB / 2, WS_WCP = WS_WAP + MiB, WS_WOUT = WS_WCP + MiB, WS_WGU = WS_WOUT + 2 * MiB, WS_WD = WS_WGU + 44 * MiB;
constexpr size_t AB = 79 * MiB;
constexpr size_t R1024 = (size_t)M * 1024 * 2, R512 = (size_t)M * 512 * 2, R128 = (size_t)M * 128 * 2;
constexpr size_t WS_H = AB, WS_Q = WS_H + R1024, WS_SGA = WS_Q + R512, WS_K = WS_SGA + R1024, WS_V = WS_K + R128, WS_GLU = WS_V + R128, WS_SGC = WS_GLU + R512, WS_CO = WS_SGC + R1024;
constexpr size_t WS_ACT = WS_Q;
constexpr size_t WS_Z = AB + 122 * MiB;
constexpr size_t WS_END = WS_Z + (size_t)M * 1024 * 4;
static_assert(WS_WD + 22 * MiB <= AB && WS_CO + R512 <= WS_END && WS_ACT + (size_t)M * DFF * 2 <= WS_Z && WS_END <= 272 * MiB, "ws map");
constexpr int CW_BAR = 4096;

constexpr int RING_BYTES = 131072, LDSCTL_OFF = RING_BYTES, MISC_OFF = LDSCTL_OFF + 320, LDS_BYTES = 147456;

__device__ __forceinline__ float wave_sum(float v) {
#pragma unroll
    for (int o = 1; o < 64; o <<= 1) v += __shfl_xor(v, o);
    return v;
}
__device__ __forceinline__ float wave_max(float v) {
#pragma unroll
    for (int o = 1; o < 64; o <<= 1) v = fmaxf(v, __shfl_xor(v, o));
    return v;
}
__device__ __forceinline__ float bfl(unsigned w) { return __builtin_bit_cast(float, w << 16); }
__device__ __forceinline__ float bfh(unsigned w) { return __builtin_bit_cast(float, w & 0xffff0000u); }
__device__ __forceinline__ float sigmoid_f(float x) { return 1.0f / (1.0f + __expf(-x)); }

__device__ __forceinline__ int winmap(int n) { return n < 768 ? n : (n < 1280 ? 768 + 2 * (n - 768) : (n < 1792 ? 769 + 2 * (n - 1280) : n)); }
__device__ __forceinline__ void transpose_item(const float* W, int K, int N, bf16* WT, int mode, int roff, LAS float* scr, int item, int lane) {
    const int nblk = N / 32, kb = item / nblk, nb = item % nblk, k0 = 64 * kb, n0 = 32 * nb;
#pragma unroll 8
    for (int i = 0; i < 32; ++i) { const int kk = 2 * i + (lane >> 5); scr[kk * 33 + (lane & 31)] = W[(size_t)(k0 + kk) * N + n0 + (lane & 31)]; }
    LDS_WAIT(); asm volatile("" ::: "memory");
    const int c = lane & 7;
#pragma unroll
    for (int j = 0; j < 4; ++j) { const int n = (lane >> 3) + 8 * j; const LAS float* s = scr + (8 * c) * 33 + n;
        v4u o; o.x = pk2(s[0 * 33], s[1 * 33]); o.y = pk2(s[2 * 33], s[3 * 33]); o.z = pk2(s[4 * 33], s[5 * 33]); o.w = pk2(s[6 * 33], s[7 * 33]);
        const int nn = n0 + n, drow = mode == 0 ? roff + nn : (mode == 1 ? roff + 2 * nn : winmap(nn));
        *(GAS v4u*)(WT + (size_t)drow * K + k0 + 8 * c) = o; }
    LDS_WAIT(); asm volatile("" ::: "memory");
}
struct Args { const float* in[25]; float* out; unsigned char* ws; };
typedef __attribute__((address_space(4))) const Args CArgs;

__device__ __forceinline__ void convert_weights(CArgs* ap, int l, LAS float* scr, int gw, int NGW, int lane_in) {
    int lane = lane_in; asm volatile("" : "+v"(lane));
    unsigned char* ws = ap->ws;
    const int nC = 1920 + 256 + 256 + 512;
    const int total = nC + (l == 0 ? 3 * 1408 : 24 * 704);
    for (int it = gw; it < total; it += NGW) {
        const float* src; bf16* dst; int K, N, mode, roff, li;
        if (it < 1920) { src = ap->in[5] + (size_t)l * 1024 * INW; K = 1024; N = INW; dst = (bf16*)(ws + WS_WIN); mode = 2; roff = 0; li = it; }
        else if (it < 2176) { src = ap->in[11] + (size_t)l * 512 * 1024; K = 512; N = 1024; dst = (bf16*)(ws + WS_WAP); mode = 0; roff = 0; li = it - 1920; }
        else if (it < 2432) { src = ap->in[12] + (size_t)l * 512 * 1024; K = 512; N = 1024; dst = (bf16*)(ws + WS_WCP); mode = 0; roff = 0; li = it - 2176; }
        else if (it < 2944) { src = ap->in[13] + (size_t)l * 1024 * 1024; K = 1024; N = 1024; dst = (bf16*)(ws + WS_WOUT); mode = 0; roff = 0; li = it - 2432; }
        else if (l == 0) { const int r = it - nC, j = r / 1408; li = r % 1408;
            if (j == 0) { src = ap->in[16]; K = 1024; N = DFF; dst = (bf16*)(ws + WS_WGU); mode = 1; roff = 0; }
            else if (j == 1) { src = ap->in[17]; K = 1024; N = DFF; dst = (bf16*)(ws + WS_WGU); mode = 1; roff = 1; }
            else { src = ap->in[18]; K = DFF; N = 1024; dst = (bf16*)(ws + WS_WD); mode = 0; roff = 0; } }
        else { const int r = it - nC, j = r / 704, e = j / 3, kind = j % 3; li = r % 704;
            if (kind == 0) { src = ap->in[20] + (size_t)e * 1024 * DEXP; K = 1024; N = DEXP; dst = (bf16*)(ws + WS_WGU) + (size_t)e * 2 * DEXP * 1024; mode = 1; roff = 0; }
            else if (kind == 1) { src = ap->in[21] + (size_t)e * 1024 * DEXP; K = 1024; N = DEXP; dst = (bf16*)(ws + WS_WGU) + (size_t)e * 2 * DEXP * 1024; mode = 1; roff = 1; }
            else { src = ap->in[22] + (size_t)e * DEXP * 1024; K = DEXP; N = 1024; dst = (bf16*)(ws + WS_WD) + (size_t)e * 1024 * DEXP; mode = 0; roff = 0; } }
        transpose_item(src, K, N, dst, mode, roff, scr, li, lane);
    }
}

__device__ __forceinline__ void ln_row(const float* src, const float* g, const float* b, int lane, f32x4 (&v)[4]) {
    const GAS f32x4* xr = (const GAS f32x4*)src + lane;
    float s = 0.f;
#pragma unroll
    for (int j = 0; j < 4; ++j) { v[j] = xr[64 * j]; s += (v[j].x + v[j].y) + (v[j].z + v[j].w); }
    const float mean = wave_sum(s) * (1.f / 1024.f); float s2 = 0.f;
#pragma unroll
    for (int j = 0; j < 4; ++j) { v[j] = v[j] - mean; s2 += (v[j].x * v[j].x + v[j].y * v[j].y) + (v[j].z * v[j].z + v[j].w * v[j].w); }
    const float rstd = 1.f / sqrtf(wave_sum(s2) * (1.f / 1024.f) + LN_EPS);
#pragma unroll
    for (int j = 0; j < 4; ++j) { const f32x4 gg = ((const GAS f32x4*)g)[lane + 64 * j], bb = ((const GAS f32x4*)b)[lane + 64 * j]; v[j] = v[j] * rstd * gg + bb; }
}
__device__ __forceinline__ void store_row_bf16(bf16* dst, int lane, const f32x4 (&v)[4]) {
    GAS unsigned long long* o8 = (GAS unsigned long long*)dst + lane;
#pragma unroll
    for (int j = 0; j < 4; ++j) o8[64 * j] = (unsigned long long)pk2(v[j].x, v[j].y) | ((unsigned long long)pk2(v[j].z, v[j].w) << 32);
}
__device__ __forceinline__ void embed_phase(CArgs* ap, bf16* H, int gw, int NGW, int lane_in) {
    int lane = lane_in; asm volatile("" : "+v"(lane));
    for (int r = gw; r < M; r += NGW) {
        f32x4 v[4];
        if (r >= MT) {
#pragma unroll
            for (int j = 0; j < 4; ++j) v[j] = (f32x4){0.f, 0.f, 0.f, 0.f};
        } else {
            const float* src = r < MR ? ap->in[0] + (size_t)r * D : ap->in[1] + (size_t)((r - MR) & 15) * D;
            ln_row(src, ap->in[2], ap->in[3], lane, v);
        }
        store_row_bf16(H + (size_t)r * D, lane, v);
    }
}
__device__ __forceinline__ void ln_phase_bf16(const float* Z, const float* g, const float* b, bf16* H, const float* router, float* CW, int gw, int NGW, int lane_in) {
    int lane = lane_in; asm volatile("" : "+v"(lane));
    for (int r = gw; r < M; r += NGW) {
        f32x4 v[4]; ln_row(Z + (size_t)r * D, g, b, lane, v);
        store_row_bf16(H + (size_t)r * D, lane, v);
        if (router) {
            float lg[8];
#pragma unroll
            for (int e = 0; e < 8; ++e) lg[e] = 0.f;
#pragma unroll
            for (int j = 0; j < 4; ++j)
#pragma unroll
                for (int i = 0; i < 4; ++i) { const int col = 256 * j + 4 * lane + i; const f32x4 r0 = *(const GAS f32x4*)(router + (size_t)col * 8), r1 = *(const GAS f32x4*)(router + (size_t)col * 8 + 4); const float x = v[j][i];
                    lg[0] += x * r0.x; lg[1] += x * r0.y; lg[2] += x * r0.z; lg[3] += x * r0.w; lg[4] += x * r1.x; lg[5] += x * r1.y; lg[6] += x * r1.z; lg[7] += x * r1.w; }
#pragma unroll
            for (int e = 0; e < 8; ++e) lg[e] = wave_sum(lg[e]);
            int i1 = 0; float v1 = lg[0];
#pragma unroll
            for (int e = 1; e < 8; ++e) if (lg[e] > v1) { v1 = lg[e]; i1 = e; }
            int i2 = -1; float v2 = -INFINITY;
#pragma unroll
            for (int e = 0; e < 8; ++e) if (e != i1 && lg[e] > v2) { v2 = lg[e]; i2 = e; }
            const float g1 = 1.0f / (1.0f + __expf(v2 - v1)), g2 = 1.0f - g1;
            if (lane < 8) CW[(size_t)lane * M + r] = lane == i1 ? g1 : (lane == i2 ? g2 : 0.f);
        }
    }
}
__device__ __forceinline__ void ln_phase_out(const float* Z, const float* g, const float* b, float* out, int gw, int NGW, int lane_in) {
    int lane = lane_in; asm volatile("" : "+v"(lane));
    for (int r = gw; r < MR; r += NGW) {
        f32x4 v[4]; ln_row(Z + (size_t)r * D, g, b, lane, v);
        GAS f32x4* o = (GAS f32x4*)(out + (size_t)r * D) + lane;
#pragma unroll
        for (int j = 0; j < 4; ++j) o[64 * j] = v[j];
    }
}

__device__ __forceinline__ int rel_bucket(int n) {
    if (n < 16) return n;
    int b = 16; b += n >= 19; b += n >= 21; b += n >= 24; b += n >= 27; b += n >= 31; b += n >= 35; b += n >= 40; b += n >= 46; b += n >= 52; b += n >= 59; b += n >= 67; b += n >= 77; b += n >= 87; b += n >= 99; b += n >= 113;
    return b;
}
__device__ __forceinline__ void attn_naive_phase(const bf16* Q, const bf16* Kb, const bf16* Vb, bf16* AO, const float* rel_bias, const float* sinks, LAS float* pl, int row_lo, int row_hi, int gw, int NGW, int lane_in) {
    int lane = lane_in; asm volatile("" : "+v"(lane));
    for (int it = gw; it < (row_hi - row_lo) * 8; it += NGW) {
        const int row = row_lo + (it >> 3), hq = it & 7, hkv = hq >> 2;
        int b, pos, s, nmeta, band_lo, nband;
        if (row < MR) { b = row >> 11; s = row & 2047; pos = 16 + s; nmeta = 16; band_lo = s - 127 < 0 ? 0 : s - 127; nband = s - band_lo + 1; }
        else { const int mi = row - MR; b = mi >> 4; pos = mi & 15; s = 0; nmeta = pos + 1; band_lo = 0; nband = 0; }
        const int nkeys = nmeta + nband;
        unsigned qw[32];
        { const GAS v4u* qp = (const GAS v4u*)(Q + (size_t)row * 512 + hq * 64);
#pragma unroll
          for (int i = 0; i < 8; ++i) { const v4u t = qp[i]; qw[4 * i] = t.x; qw[4 * i + 1] = t.y; qw[4 * i + 2] = t.z; qw[4 * i + 3] = t.w; } }
        const float sink = sinks[hq];
        float sc[3]; float mx = -INFINITY;
#pragma unroll
        for (int c = 0; c < 3; ++c) {
            const int j = c * 64 + lane; const bool valid = j < nkeys;
            const int jj = valid ? j : 0;
            const int krow = jj < nmeta ? MR + b * 16 + jj : b * 2048 + band_lo + (jj - nmeta);
            const int dist = jj < nmeta ? pos - jj : s - (band_lo + jj - nmeta);
            const GAS v4u* kp = (const GAS v4u*)(Kb + (size_t)krow * 128 + hkv * 64);
            float dot = 0.f;
#pragma unroll
            for (int i = 0; i < 8; ++i) { const v4u t = kp[i];
                dot += bfl(qw[4 * i]) * bfl(t.x) + bfh(qw[4 * i]) * bfh(t.x) + bfl(qw[4 * i + 1]) * bfl(t.y) + bfh(qw[4 * i + 1]) * bfh(t.y)
                     + bfl(qw[4 * i + 2]) * bfl(t.z) + bfh(qw[4 * i + 2]) * bfh(t.z) + bfl(qw[4 * i + 3]) * bfl(t.w) + bfh(qw[4 * i + 3]) * bfh(t.w); }
            sc[c] = valid ? dot * 0.125f + rel_bias[rel_bucket(dist) * 8 + hq] : -INFINITY;
            mx = fmaxf(mx, sc[c]);
        }
        mx = fmaxf(wave_max(mx), sink);
        float ps = 0.f;
#pragma unroll
        for (int c = 0; c < 3; ++c) { const float p = __expf(sc[c] - mx); ps += p; pl[c * 64 + lane] = p; }
        const float denom = wave_sum(ps) + __expf(sink - mx);
        LDS_WAIT(); asm volatile("" ::: "memory");
        float o = 0.f;
#pragma unroll 8
        for (int j = 0; j < nkeys; ++j) {
            const int krow = j < nmeta ? MR + b * 16 + j : b * 2048 + band_lo + (j - nmeta);
            o += pl[j] * bfl((unsigned)Vb[(size_t)krow * 128 + hkv * 64 + lane]);
        }
        LDS_WAIT(); asm volatile("" ::: "memory");
        AO[(size_t)row * 512 + hq * 64 + lane] = (bf16)f2bf(o / denom);
    }
}

namespace att {
typedef short bf16x8 __attribute__((ext_vector_type(8)));
typedef short s16x4 __attribute__((ext_vector_type(4)));
typedef float f32x16 __attribute__((ext_vector_type(16)));
typedef float f32x2_t __attribute__((ext_vector_type(2))); typedef __bf16 bf16x2_t __attribute__((ext_vector_type(2)));
constexpr int NK = 288, NG = 18;
constexpr int LK = 0, LV = NK * 128, LBIAS = 2 * NK * 128, LWS = LBIAS + 2048, LOST = LWS + 2048, LEND = LOST + 32768;
__device__ __forceinline__ int crow(int r, int hi) { return (r & 3) + 8 * (r >> 2) + 4 * hi; }
__device__ __forceinline__ unsigned cvtpk_s(float lo, float hi) { f32x2_t v = {lo, hi}; bf16x2_t b = __builtin_convertvector(v, bf16x2_t); return __builtin_bit_cast(unsigned, b); }
typedef __attribute__((address_space(3))) const char* lds_cptr;
typedef short v4i16_t __attribute__((ext_vector_type(4)));
__device__ __forceinline__ s16x4 vtr(lds_cptr p) { return __builtin_bit_cast(s16x4, __builtin_amdgcn_ds_read_tr16_b64_v4i16((__attribute__((address_space(3))) v4i16_t*)p)); }

__device__ __forceinline__ void attn_unit(int b, int n, int hkv, const bf16* Q, const bf16* Kg, const bf16* Vg, bf16* AO, const float* relb, const float* sinks, LAS unsigned char* L) {
    int tid_ = threadIdx.x; asm volatile("" : "+v"(tid_));
    const int tid = tid_, lane = tid & 63, r32 = lane & 31, hi = lane >> 5; const int wid = __builtin_amdgcn_readfirstlane(tid >> 6);
    { const int g = tid >> 7, dist = tid & 127; ((LAS float*)(L + LBIAS))[tid] = relb[rel_bucket(dist) * 8 + hkv * 4 + g]; }
    for (int idx = tid; idx < NK * 8; idx += 512) {
        const int key = idx >> 3, c = idx & 7; int row = -1;
        if (key < 16) row = MR + b * 16 + key;
        else if (key >= 32) { const int sp = (n - 1) * 128 + (key - 32); if (sp >= 0) row = b * 2048 + sp; }
        v4u kv = (v4u){0u, 0u, 0u, 0u}, vv = (v4u){0u, 0u, 0u, 0u};
        if (row >= 0) { kv = *(const GAS v4u*)(Kg + (size_t)row * 128 + hkv * 64 + c * 8); vv = *(const GAS v4u*)(Vg + (size_t)row * 128 + hkv * 64 + c * 8); }
        *(LAS v4u*)(L + LK + c * (NK * 16) + key * 16) = kv;
        *(LAS v4u*)(L + LV + ((c >> 2) * NG + (key >> 4)) * 1024 + (key & 15) * 64 + (c & 3) * 16) = vv;
    }
    __syncthreads();
    const int g = wid >> 1, qh = wid & 1, hq = hkv * 4 + g;
    const float sink = sinks[hq];
    const LAS float* biasT = (const LAS float*)(L + LBIAS) + g * 128;
    LAS float* wsf = (LAS float*)(L + LWS) + wid * 64;
    LAS bf16* stg = (LAS bf16*)(L + LOST) + wid * 2048;
    const int voff = ((lane >> 4) & 1) * 32 + (lane & 3) * 8 + (4 * hi + ((lane & 15) >> 2)) * 64;
    for (int sb = 0; sb < 2; ++sb) {
        const int a0 = 64 * qh + 32 * sb, a = a0 + r32, t0 = a0 >> 5;
        const size_t qrow = (size_t)b * 2048 + n * 128 + a;
        bf16x8 qr[4];
#pragma unroll
        for (int d0 = 0; d0 < 4; ++d0) qr[d0] = *(const GAS bf16x8*)(Q + qrow * 512 + hq * 64 + d0 * 16 + hi * 8);
        f32x16 S[6];
#pragma unroll
        for (int jt = 0; jt < 6; ++jt) { const int kt = jt == 0 ? 0 : t0 + jt; f32x16 acc = {};
#pragma unroll
            for (int d0 = 0; d0 < 4; ++d0) { const bf16x8 kf = *(const LAS bf16x8*)(L + LK + (d0 * 2 + hi) * (NK * 16) + (kt * 32 + r32) * 16); acc = __builtin_amdgcn_mfma_f32_32x32x16_bf16(kf, qr[d0], acc, 0, 0, 0); }
            S[jt] = acc; }
        const int posq = 16 + n * 128 + a; float mx = -INFINITY;
#pragma unroll
        for (int r = 0; r < 16; ++r) { const int m = crow(r, hi); const bool valid = m < 16; const int dist = posq - m; const int di = valid ? (dist > 127 ? 127 : dist) : 0;
            const float bs = biasT[di]; const float v = valid ? S[0][r] * 0.125f + bs : -INFINITY; S[0][r] = v; mx = fmaxf(mx, v); }
#pragma unroll
        for (int jt = 1; jt < 6; ++jt)
#pragma unroll
            for (int r = 0; r < 16; ++r) { const int kk = 32 * (t0 + jt - 1) + crow(r, hi); const int dist = 128 + a - kk; const bool valid = dist >= 0 && dist < 128 && (n > 0 || kk >= 128);
                const float bs = biasT[valid ? dist : 0]; const float v = valid ? S[jt][r] * 0.125f + bs : -INFINITY; S[jt][r] = v; mx = fmaxf(mx, v); }
        mx = fmaxf(mx, __shfl_xor(mx, 32)); const float mrow = fmaxf(mx, sink);
        float l = 0.f;
#pragma unroll
        for (int jt = 0; jt < 6; ++jt)
#pragma unroll
            for (int r = 0; r < 16; ++r) { const float p = __expf(S[jt][r] - mrow); S[jt][r] = p; l += p; }
        l += __shfl_xor(l, 32); l += __expf(sink - mrow);
        f32x16 o[2]; o[0] = f32x16{}; o[1] = f32x16{};
#pragma unroll
        for (int jt = 0; jt < 6; ++jt) { const int kt = jt == 0 ? 0 : t0 + jt;
#pragma unroll
            for (int h2 = 0; h2 < 2; ++h2) { v4u pw; pw.x = cvtpk_s(S[jt][8 * h2 + 0], S[jt][8 * h2 + 1]); pw.y = cvtpk_s(S[jt][8 * h2 + 2], S[jt][8 * h2 + 3]); pw.z = cvtpk_s(S[jt][8 * h2 + 4], S[jt][8 * h2 + 5]); pw.w = cvtpk_s(S[jt][8 * h2 + 6], S[jt][8 * h2 + 7]);
                const bf16x8 pa = __builtin_bit_cast(bf16x8, pw); const int grp = 2 * kt + h2;
#pragma unroll
                for (int dh = 0; dh < 2; ++dh) { const lds_cptr vp = (lds_cptr)(L + LV + (dh * NG + grp) * 1024 + voff); const s16x4 lo = vtr(vp), hh = vtr(vp + 512);
                    const bf16x8 vf = (bf16x8){lo[0], lo[1], lo[2], lo[3], hh[0], hh[1], hh[2], hh[3]}; o[dh] = __builtin_amdgcn_mfma_f32_32x32x16_bf16(pa, vf, o[dh], 0, 0, 0); } } }
        if (hi == 0) wsf[r32] = l;
        LDS_WAIT(); asm volatile("" ::: "memory");
#pragma unroll
        for (int r = 0; r < 16; ++r) { const int q = crow(r, hi); const float rl = 1.0f / wsf[q];
#pragma unroll
            for (int dh = 0; dh < 2; ++dh) stg[q * 64 + dh * 32 + r32] = (bf16)f2bf(o[dh][r] * rl); }
        LDS_WAIT(); asm volatile("" ::: "memory");
#pragma unroll
        for (int i = 0; i < 4; ++i) { const int row = i * 8 + (lane >> 3), ch = lane & 7; const v4u v = *(const LAS v4u*)(stg + row * 64 + ch * 8);
            *(GAS v4u*)(AO + ((size_t)b * 2048 + n * 128 + a0 + row) * 512 + hq * 64 + ch * 8) = v; }
        LDS_WAIT(); asm volatile("" ::: "memory");
    }
    __syncthreads();
}
}

__device__ __forceinline__ void conv_naive_phase(const bf16* GLU, bf16* CO, const float* dw, const float* db, const float* lg, const float* lb, int row_lo, int gw, int NGW, int lane_in) {
    int lane = lane_in; asm volatile("" : "+v"(lane));
    for (int row = row_lo + gw; row < M; row += NGW) {
        if (row >= MT) { *(GAS v4u*)(CO + (size_t)row * 512 + 8 * lane) = (v4u){0u, 0u, 0u, 0u}; continue; }
        int b, pos;
        if (row < MR) { b = row >> 11; pos = 16 + (row & 2047); } else { const int mi = row - MR; b = mi >> 4; pos = mi & 15; }
        float acc[8];
        { const f32x4 b0 = *(const GAS f32x4*)(db + 8 * lane), b1 = *(const GAS f32x4*)(db + 8 * lane + 4); acc[0] = b0.x; acc[1] = b0.y; acc[2] = b0.z; acc[3] = b0.w; acc[4] = b1.x; acc[5] = b1.y; acc[6] = b1.z; acc[7] = b1.w; }
        for (int j = 0; j < 31; ++j) {
            const int p = pos - 30 + j; if (p < 0) continue;
            const int r2 = p < 16 ? MR + b * 16 + p : b * 2048 + p - 16;
            const v4u t = *(const GAS v4u*)(GLU + (size_t)r2 * 512 + 8 * lane);
            const f32x4 w0 = *(const GAS f32x4*)(dw + (size_t)j * 512 + 8 * lane), w1 = *(const GAS f32x4*)(dw + (size_t)j * 512 + 8 * lane + 4);
            acc[0] += bfl(t.x) * w0.x; acc[1] += bfh(t.x) * w0.y; acc[2] += bfl(t.y) * w0.z; acc[3] += bfh(t.y) * w0.w;
            acc[4] += bfl(t.z) * w1.x; acc[5] += bfh(t.z) * w1.y; acc[6] += bfl(t.w) * w1.z; acc[7] += bfh(t.w) * w1.w;
        }
        float s = 0.f;
#pragma unroll
        for (int i = 0; i < 8; ++i) s += acc[i];
        const float mean = wave_sum(s) * (1.f / 512.f); float s2 = 0.f;
#pragma unroll
        for (int i = 0; i < 8; ++i) { acc[i] -= mean; s2 += acc[i] * acc[i]; }
        const float rstd = 1.f / sqrtf(wave_sum(s2) * (1.f / 512.f) + LN_EPS);
        float y[8];
#pragma unroll
        for (int i = 0; i < 8; ++i) { const float t = acc[i] * rstd * lg[8 * lane + i] + lb[8 * lane + i]; y[i] = t * sigmoid_f(t); }
        v4u o; o.x = pk2(y[0], y[1]); o.y = pk2(y[2], y[3]); o.z = pk2(y[4], y[5]); o.w = pk2(y[6], y[7]);
        *(GAS v4u*)(CO + (size_t)row * 512 + 8 * lane) = o;
    }
}


namespace cv {
typedef float f32x2 __attribute__((ext_vector_type(2)));
template <int I> __device__ __forceinline__ void conv_rows(f32x2 (&acc)[32], const f32x2 (&w)[31], const LAS unsigned char* base) {
    if constexpr (I < 62) {
        const unsigned xw = *(const LAS unsigned*)(base + I * 1024);
        const f32x2 x = (f32x2){bfl(xw), bfh(xw)};
#pragma unroll
        for (int t = 0; t < 32; ++t) if (I - t >= 0 && I - t <= 30) acc[t] += x * w[I - t];
        conv_rows<I + 1>(acc, w, base);
    }
}
__device__ __forceinline__ void conv_unit(int b, int c, const bf16* GLUg, bf16* COg, const float* dw, const float* db, const float* lg, const float* lb, LAS unsigned char* L) {
    int tid_ = threadIdx.x; asm volatile("" : "+v"(tid_));
    const int tid = tid_, lane = tid & 63; const int wid = __builtin_amdgcn_readfirstlane(tid >> 6);
    const int s0 = 64 * c;
    for (int idx = tid; idx < 94 * 64; idx += 512) {
        const int i = idx >> 6, ch = idx & 63; const int sp = s0 - 30 + i; int row = -1;
        if (sp >= 0) row = b * 2048 + sp; else if (sp >= -16) row = MR + b * 16 + (16 + sp);
        v4u v = (v4u){0u, 0u, 0u, 0u};
        if (row >= 0) v = *(const GAS v4u*)(GLUg + (size_t)row * 512 + ch * 8);
        *(LAS v4u*)(L + i * 1024 + ch * 16) = v;
    }
    const int cp = tid & 255, th = tid >> 8;
    f32x2 w[31];
#pragma unroll
    for (int j = 0; j < 31; ++j) w[j] = *(const GAS f32x2*)(dw + (size_t)j * 512 + 2 * cp);
    const f32x2 bias = *(const GAS f32x2*)(db + 2 * cp);
    f32x2 acc[32];
#pragma unroll
    for (int t = 0; t < 32; ++t) acc[t] = bias;
    __syncthreads();
    conv_rows<0>(acc, w, L + (32 * th) * 1024 + cp * 4);
    __syncthreads();
#pragma unroll
    for (int t = 0; t < 32; ++t) *(LAS f32x2*)(L + (32 * th + t) * 2048 + cp * 8) = acc[t];
    __syncthreads();
    f32x4 g0 = *(const GAS f32x4*)(lg + 8 * lane), g1 = *(const GAS f32x4*)(lg + 8 * lane + 4), b0 = *(const GAS f32x4*)(lb + 8 * lane), b1 = *(const GAS f32x4*)(lb + 8 * lane + 4);
    for (int k = 0; k < 8; ++k) {
        const int T = 8 * wid + k;
        f32x4 y0 = *(const LAS f32x4*)(L + T * 2048 + lane * 32), y1 = *(const LAS f32x4*)(L + T * 2048 + lane * 32 + 16);
        const float mean = wave_sum((y0.x + y0.y) + (y0.z + y0.w) + (y1.x + y1.y) + (y1.z + y1.w)) * (1.f / 512.f);
        y0 = y0 - mean; y1 = y1 - mean;
        const float rstd = 1.f / sqrtf(wave_sum((y0.x * y0.x + y0.y * y0.y) + (y0.z * y0.z + y0.w * y0.w) + (y1.x * y1.x + y1.y * y1.y) + (y1.z * y1.z + y1.w * y1.w)) * (1.f / 512.f) + LN_EPS);
        y0 = y0 * rstd * g0 + b0; y1 = y1 * rstd * g1 + b1;
        v4u o; o.x = pk2(y0.x * sigmoid_f(y0.x), y0.y * sigmoid_f(y0.y)); o.y = pk2(y0.z * sigmoid_f(y0.z), y0.w * sigmoid_f(y0.w));
        o.z = pk2(y1.x * sigmoid_f(y1.x), y1.y * sigmoid_f(y1.y)); o.w = pk2(y1.z * sigmoid_f(y1.z), y1.w * sigmoid_f(y1.w));
        *(GAS v4u*)(COg + ((size_t)b * 2048 + s0 + T) * 512 + 8 * lane) = o;
    }
    __syncthreads();
}
}

#define HB ((bf16*)(ws + WS_H))
#define QB ((bf16*)(ws + WS_Q))
#define SGA ((bf16*)(ws + WS_SGA))
#define KB ((bf16*)(ws + WS_K))
#define VB ((bf16*)(ws + WS_V))
#define GLU ((bf16*)(ws + WS_GLU))
#define SGC ((bf16*)(ws + WS_SGC))
#define CO ((bf16*)(ws + WS_CO))
#define ACT ((bf16*)(ws + WS_ACT))
#define Z ((float*)(ws + WS_Z))
#define CW ((float*)(ws + WS_CW))
#define Win_t ((bf16*)(ws + WS_WIN))
#define Wap_t ((bf16*)(ws + WS_WAP))
#define Wcp_t ((bf16*)(ws + WS_WCP))
#define Wout_t ((bf16*)(ws + WS_WOUT))
#define Wgu_t ((bf16*)(ws + WS_WGU))
#define Wd_t ((bf16*)(ws + WS_WD))
#define PHASE_CTX() CArgs* ap = (CArgs*)__builtin_amdgcn_kernarg_segment_ptr(); asm volatile("" : "+s"(ap)); unsigned char* ws = ap->ws; \
    int lane = threadIdx.x & 63; asm volatile("" : "+v"(lane)); const int wave = __builtin_amdgcn_readfirstlane(threadIdx.x >> 6); \
    const int G = gridDim.x, gw = blockIdx.x * NWAVES + wave, NGW = G * NWAVES; (void)lane; (void)gw; (void)NGW; (void)ws
#define GRID_BAR() xcd_barrier(bar)
__global__ void __launch_bounds__(NWAVES * 64, 2) fwd_kernel(Args a_unused) {
    extern __shared__ __attribute__((aligned(16))) unsigned char lds[];
    LAS unsigned char* L = (LAS unsigned char*)lds;
    XcdBarrier bar;
    { PHASE_CTX();
      for (int u = threadIdx.x; u < (LDS_BYTES - LDSCTL_OFF) / 4; u += NWAVES * 64) ((LAS unsigned*)(L + LDSCTL_OFF))[u] = 0u;
      __syncthreads();
      bar = xcd_barrier_post((unsigned*)(ws + WS_CTL) + CW_BAR, (volatile LAS unsigned*)(L + MISC_OFF) + 8);
      convert_weights(ap, 0, (LAS float*)(L + wave * 16384), gw, NGW, lane);
      embed_phase(ap, HB, gw, NGW, lane); }
    GRID_BAR();

    for (int l = 0; l < 2; ++l) {
        { PHASE_CTX(); pg8::Gemm g{HB, Win_t, M, INW, 1024}; pg8::StaticOrder S; S.init(M, INW, G, (int)blockIdx.x);
          pg8::EpiWin E{QB, KB, VB, GLU, SGA, SGC};
          pg8::gemm_phase<pg8::EpiWin, pg8::StaticOrder, true, true>(L, g, S, E); }
        GRID_BAR();
        { PHASE_CTX(); for (int u = blockIdx.x; u < 256; u += G) att::attn_unit(u >> 5, (u >> 1) & 15, u & 1, QB, KB, VB, QB, ap->in[4], ap->in[10] + l * 8, L); }
        if (l == 0) { PHASE_CTX(); attn_naive_phase(QB, KB, VB, QB, ap->in[4], ap->in[10] + l * 8, (LAS float*)(L + wave * 1024), MR, MT, gw, NGW, lane); }
        { PHASE_CTX(); for (int u = blockIdx.x; u < 256; u += G) cv::conv_unit(u >> 5, u & 31, GLU, CO, ap->in[6] + (size_t)l * 31 * 512, ap->in[7] + l * 512, ap->in[8] + l * 512, ap->in[9] + l * 512, L); }
        { PHASE_CTX(); conv_naive_phase(GLU, CO, ap->in[6] + (size_t)l * 31 * 512, ap->in[7] + l * 512, ap->in[8] + l * 512, ap->in[9] + l * 512, MR, gw, NGW, lane); }
        GRID_BAR();
        for (int pass = 0; pass < 2; ++pass) {
            { PHASE_CTX(); pg8::Gemm g{pass ? CO : QB, pass ? Wcp_t : Wap_t, M, 1024, 512}; pg8::StaticOrder S; S.init(M, 1024, G, (int)blockIdx.x);
              pg8::EpiGate E{SGA, pass ? SGC : SGA, pass};
              pg8::gemm_phase<pg8::EpiGate, pg8::StaticOrder, true, true>(L, g, S, E); }
            GRID_BAR();
        }
        { PHASE_CTX(); pg8::Gemm g{SGA, Wout_t, M, 1024, 1024}; pg8::StaticOrder S; S.init(M, 1024, G, (int)blockIdx.x);
          pg8::EpiResF32 E{Z, HB, nullptr, 0, ALPHA};
          pg8::gemm_phase<pg8::EpiResF32, pg8::StaticOrder, true, true>(L, g, S, E); }
        GRID_BAR();
        { PHASE_CTX(); ln_phase_bf16(Z, ap->in[14] + l * D, ap->in[15] + l * D, HB, l == 1 ? ap->in[19] : nullptr, CW, gw, NGW, lane); }
        GRID_BAR();
        if (l == 0) {
            { PHASE_CTX(); pg8::Gemm g{HB, Wgu_t, M, 2 * DFF, 1024}; pg8::StaticOrder S; S.init(M, 2 * DFF, G, (int)blockIdx.x);
              pg8::EpiSwiGLU E{ACT, DFF};
              pg8::gemm_phase<pg8::EpiSwiGLU, pg8::StaticOrder, true, true>(L, g, S, E); }
            GRID_BAR();
            { PHASE_CTX(); pg8::Gemm g{ACT, Wd_t, M, 1024, DFF}; pg8::StaticOrder S; S.init(M, 1024, G, (int)blockIdx.x);
              pg8::EpiResF32 E{Z, HB, nullptr, 0, ALPHA};
              pg8::gemm_phase<pg8::EpiResF32, pg8::StaticOrder, true, true>(L, g, S, E); }
            GRID_BAR();
            { PHASE_CTX(); ln_phase_bf16(Z, ap->in[23], ap->in[24], HB, nullptr, nullptr, gw, NGW, lane); }
            { PHASE_CTX(); convert_weights(ap, 1, (LAS float*)(L + wave * 16384), gw, NGW, lane); }
            GRID_BAR();
        } else {
            for (int e = 0; e < NEXP; ++e) {
                { PHASE_CTX(); pg8::Gemm g{HB, Wgu_t + (size_t)e * 2 * DEXP * 1024, M, 2 * DEXP, 1024}; pg8::StaticOrder S; S.init(M, 2 * DEXP, G, (int)blockIdx.x);
                  pg8::EpiSwiGLU E{ACT, DEXP};
                  pg8::gemm_phase<pg8::EpiSwiGLU, pg8::StaticOrder, true, true>(L, g, S, E); }
                GRID_BAR();
                { PHASE_CTX(); pg8::Gemm g{ACT, Wd_t + (size_t)e * 1024 * DEXP, M, 1024, DEXP}; pg8::StaticOrder S; S.init(M, 1024, G, (int)blockIdx.x);
                  pg8::EpiResF32 E{Z, HB, CW + (size_t)e * M, e == 0 ? 1 : 2, ALPHA};
                  pg8::gemm_phase<pg8::EpiResF32, pg8::StaticOrder, true, true>(L, g, S, E); }
                GRID_BAR();
            }
            { PHASE_CTX(); ln_phase_out(Z, ap->in[23] + D, ap->in[24] + D, ap->out, gw, NGW, lane); }
        }
    }
}

extern "C" void kernel_launch(void* const* d_in, const int* in_sizes, int n_in, void* d_out, int out_size, void* d_ws, size_t ws_size, hipStream_t stream) {
    static int grid = 0;
    if (grid == 0) {
        if (n_in != 25 || out_size != MR * D || ws_size < WS_END) { fprintf(stderr, "kernel_launch: unexpected shapes (n_in %d, out %d, ws %zu, need %zu)\n", n_in, out_size, ws_size, (size_t)WS_END); grid = -1; return; }
        int dev = 0, cus = 0, per_cu = 0;
        if (hipGetDevice(&dev) != hipSuccess || hipDeviceGetAttribute(&cus, hipDeviceAttributeMultiprocessorCount, dev) != hipSuccess) { grid = -1; return; }
        if (hipFuncSetAttribute((const void*)fwd_kernel, hipFuncAttributeMaxDynamicSharedMemorySize, LDS_BYTES) != hipSuccess) { fprintf(stderr, "kernel_launch: hipFuncSetAttribute failed\n"); grid = -1; return; }
        if (hipOccupancyMaxActiveBlocksPerMultiprocessor(&per_cu, (const void*)fwd_kernel, NWAVES * 64, LDS_BYTES) != hipSuccess || per_cu < 1) { fprintf(stderr, "kernel_launch: occupancy query says %d blocks per CU\n", per_cu); grid = -1; (void)hipGetLastError(); return; }
        (void)hipGetLastError();
        grid = cus;
    }
    if (grid < 0) return;
    if (hipMemsetAsync((char*)d_ws + WS_CTL, 0, CTL_ZERO_BYTES, stream) != hipSuccess) return;
    Args a{};
    for (int i = 0; i < 25; ++i) a.in[i] = (const float*)d_in[i];
    a.out = (float*)d_out; a.ws = (unsigned char*)d_ws;
    hipLaunchKernelGGL(fwd_kernel, dim3(grid), dim3(NWAVES * 64), LDS_BYTES, stream, a);
}
```

```cpp
#include <hip/hip_runtime.h>
#include <cstdio>
#include <cstdint>
#include <cmath>
namespace pg8 {
#define PG8_LAS __attribute__((address_space(3)))
typedef unsigned short bf16_t;
typedef short bf16x8 __attribute__((ext_vector_type(8)));
typedef float f32x4 __attribute__((ext_vector_type(4)));
typedef unsigned u32x4 __attribute__((ext_vector_type(4)));
constexpr int BM = 256, BK = 64, HALF = 128, HTB = HALF * BK * 2  , STAGE_BYTES = 8 * HTB, NXCD = 8, WGM = 8;

__host__ __device__ __forceinline__ int lds_byte(int r, int c) { const int st = (r >> 4) * 2 + (c >> 5), rr = r & 15, cc = c & 31, ob = rr * 64 + cc * 2; return st * 1024 + (ob ^ (((ob >> 9) & 1) << 5)); }
__host__ __device__ __forceinline__ void stage_rc(int b, int& R, int& C) { const int st = b / 1024, sb = b % 1024, swz = sb ^ (((sb >> 9) & 1) << 5); R = (st >> 1) * 16 + swz / 64; C = (st & 1) * 32 + (swz % 64) / 2; }
__host__ __device__ __forceinline__ int perm32(int rho) { const int n = rho >> 4, i = rho & 15; return 8 * (i >> 2) + 4 * n + (i & 3); }

struct Unit { int pm, pn; int arow, pnb, orow, nvalid; const int* gix; };
struct Gemm { const bf16_t* A; const bf16_t* Bt; int M, N, K; };

struct StaticOrder {
    int nM, nN, nwg, G, c;
    __host__ __device__ void init(int M, int N, int G_, int c_) { nM = M / BM; nN = N / BM; nwg = nM * nN; G = G_; c = c_; }
    __host__ __device__ bool next(int i, Unit& u) const {
        const long L = (long)i * G + c; if (L >= nwg) return false;
        int wgid = (int)L; { const int q = nwg / NXCD, r = nwg % NXCD, xcd = wgid % NXCD, off = wgid / NXCD; wgid = (xcd < r ? xcd * (q + 1) : r * (q + 1) + (xcd - r) * q) + off; }
        const int nig = WGM * nN, gid = wgid / nig, fm = gid * WGM, gsz = (nM - fm) < WGM ? (nM - fm) : WGM;
        u.pm = fm + ((wgid % nig) % gsz); u.pn = (wgid % nig) / gsz; u.arow = u.pm * BM; u.orow = u.pm * BM; u.pnb = u.pn; u.nvalid = BM; u.gix = nullptr; return true;
    }
    __device__ __forceinline__ void a_ready(const Unit&) const {}
    __device__ __forceinline__ void done(const Unit&) const {}
};

__device__ __forceinline__ unsigned cvt_pk_bf16(float lo, float hi) { unsigned r; asm volatile("v_cvt_pk_bf16_f32 %0, %1, %2" : "=v"(r) : "v"(lo), "v"(hi)); return r; }
typedef float f32x2 __attribute__((ext_vector_type(2)));
typedef unsigned u32x2 __attribute__((ext_vector_type(2)));
__device__ __forceinline__ float bf_lo(unsigned w) { return __builtin_bit_cast(float, w << 16); }
__device__ __forceinline__ float bf_hi(unsigned w) { return __builtin_bit_cast(float, w & 0xffff0000u); }
__device__ __forceinline__ float sigm(float x) { return __builtin_amdgcn_rcpf(1.0f + __builtin_amdgcn_exp2f(-1.4426950408889634f * x)); }
__device__ __forceinline__ u32x4 pack8(const f32x4 a, const f32x4 b) { u32x4 w; w.x = cvt_pk_bf16(a[0], a[1]); w.y = cvt_pk_bf16(a[2], a[3]); w.z = cvt_pk_bf16(b[0], b[1]); w.w = cvt_pk_bf16(b[2], b[3]); return w; }
__device__ __forceinline__ void unpack8(const u32x4 w, f32x4& a, f32x4& b) { a = (f32x4){bf_lo(w.x), bf_hi(w.x), bf_lo(w.y), bf_hi(w.y)}; b = (f32x4){bf_lo(w.z), bf_hi(w.z), bf_lo(w.w), bf_hi(w.w)}; }

struct EpiWin {
    static constexpr bool PERM = true, AFTER_DRAIN = false;
    bf16_t *Q, *Kb, *Vb, *GLU, *SGA, *SGC;
    __device__ __forceinline__ void operator()(const f32x4 (&acc)[2][2][4][2], const Unit& u, int wr, int wc, int fr, int fq) const {
        const int row0 = u.orow + wr * 64 + fr, pn = u.pn, cin = wc * 32 + 8 * fq;
#pragma unroll
        for (int ai = 0; ai < 2; ++ai)
#pragma unroll
            for (int m = 0; m < 4; ++m) { const size_t row = (size_t)(row0 + ai * HALF + m * 16);
#pragma unroll
                for (int bj = 0; bj < 2; ++bj) { const f32x4 v0 = acc[ai][bj][m][0], v1 = acc[ai][bj][m][1];
                    if (pn < 2) { *(u32x4*)(Q + row * 512 + pn * 256 + bj * HALF + cin) = pack8(v0, v1); }
                    else if (pn == 2) { bf16_t* base = bj ? Vb : Kb; *(u32x4*)(base + row * 128 + cin) = pack8(v0, v1); }
                    else if (pn < 7) { u32x2 w; w.x = cvt_pk_bf16(v0[0] * sigm(v0[1]), v0[2] * sigm(v0[3])); w.y = cvt_pk_bf16(v1[0] * sigm(v1[1]), v1[2] * sigm(v1[3]));
                        *(u32x2*)(GLU + row * 512 + (pn - 3) * 128 + bj * 64 + (cin >> 1)) = w; }
                    else { const f32x4 s0 = (f32x4){sigm(v0[0]), sigm(v0[1]), sigm(v0[2]), sigm(v0[3])}, s1 = (f32x4){sigm(v1[0]), sigm(v1[1]), sigm(v1[2]), sigm(v1[3])};
                        bf16_t* base = pn < 11 ? SGA + (pn - 7) * 256 : SGC + (pn - 11) * 256; *(u32x4*)(base + row * 1024 + bj * HALF + cin) = pack8(s0, s1); } } }
    }
};
struct EpiGate {
    static constexpr bool PERM = true, AFTER_DRAIN = false;
    bf16_t* G; const bf16_t* S; int add;
    __device__ __forceinline__ void operator()(const f32x4 (&acc)[2][2][4][2], const Unit& u, int wr, int wc, int fr, int fq) const {
        const int row0 = u.orow + wr * 64 + fr, col0 = u.pn * BM + wc * 32 + 8 * fq;
#pragma unroll
        for (int ai = 0; ai < 2; ++ai)
#pragma unroll
            for (int m = 0; m < 4; ++m) { const size_t off = (size_t)(row0 + ai * HALF + m * 16) * 1024 + col0;
#pragma unroll
                for (int bj = 0; bj < 2; ++bj) { f32x4 s0, s1; unpack8(*(const u32x4*)(S + off + bj * HALF), s0, s1);
                    f32x4 o0 = s0 * acc[ai][bj][m][0], o1 = s1 * acc[ai][bj][m][1];
                    if (add) { f32x4 g0, g1; unpack8(*(const u32x4*)(G + off + bj * HALF), g0, g1); o0 += g0; o1 += g1; }
                    *(u32x4*)(G + off + bj * HALF) = pack8(o0, o1); }
                asm volatile("" ::: "memory"); }
    }
};
struct EpiResF32 {
    static constexpr bool PERM = false, AFTER_DRAIN = false;
    float* Z; const bf16_t* H; const float* cw; int mode; float alpha;
    __device__ __forceinline__ void operator()(const f32x4 (&acc)[2][2][4][2], const Unit& u, int wr, int wc, int fr, int fq) const {
        const int row0 = u.orow + wr * 64 + fr, col0 = u.pn * BM + wc * 32 + 4 * fq;
#pragma unroll
        for (int ai = 0; ai < 2; ++ai)
#pragma unroll
            for (int m = 0; m < 4; ++m) { const int row = row0 + ai * HALF + m * 16; const size_t off = (size_t)row * 1024 + col0;
                const float c = mode ? cw[row] : 1.0f;
#pragma unroll
                for (int bj = 0; bj < 2; ++bj)
#pragma unroll
                    for (int n = 0; n < 2; ++n) { const size_t o = off + bj * HALF + n * 16; f32x4 base;
                        if (mode == 2) base = *(const f32x4*)(Z + o);
                        else { const u32x2 hw = *(const u32x2*)(H + o); base = (f32x4){bf_lo(hw.x), bf_hi(hw.x), bf_lo(hw.y), bf_hi(hw.y)} * alpha; }
                        *(f32x4*)(Z + o) = base + acc[ai][bj][m][n] * c; }
                asm volatile("" ::: "memory"); }
    }
};
struct EpiSwiGLU {
    static constexpr bool PERM = true, AFTER_DRAIN = false;
    bf16_t* O; int ldc;
    __device__ __forceinline__ void operator()(const f32x4 (&acc)[2][2][4][2], const Unit& u, int wr, int wc, int fr, int fq) const {
        const int row0 = u.orow + wr * 64 + fr, col0 = (u.pn * BM + wc * 32 + 8 * fq) >> 1;
#pragma unroll
        for (int ai = 0; ai < 2; ++ai)
#pragma unroll
            for (int m = 0; m < 4; ++m) { bf16_t* rowp = O + (size_t)(row0 + ai * HALF + m * 16) * ldc + col0;
                if (wr * 64 + fr + ai * HALF + m * 16 < u.nvalid) {
#pragma unroll
                for (int bj = 0; bj < 2; ++bj) { const f32x4 v0 = acc[ai][bj][m][0], v1 = acc[ai][bj][m][1]; u32x2 w;
                    w.x = cvt_pk_bf16(v0[0] * sigm(v0[0]) * v0[1], v0[2] * sigm(v0[2]) * v0[3]); w.y = cvt_pk_bf16(v1[0] * sigm(v1[0]) * v1[1], v1[2] * sigm(v1[2]) * v1[3]);
                    *(u32x2*)(rowp + bj * 64) = w; } } }
    }
};

struct EpiOutBf16 {
    static constexpr bool PERM = true, AFTER_DRAIN = false;
    bf16_t* O; int ldc;
    __device__ __forceinline__ void operator()(const f32x4 (&acc)[2][2][4][2], const Unit& u, int wr, int wc, int fr, int fq) const {
        const int row0 = u.orow + wr * 64 + fr, col0 = u.pn * BM + wc * 32 + 8 * fq;
#pragma unroll
        for (int ai = 0; ai < 2; ++ai)
#pragma unroll
            for (int m = 0; m < 4; ++m) { bf16_t* rowp = O + (size_t)(row0 + ai * HALF + m * 16) * ldc + col0;
                if (wr * 64 + fr + ai * HALF + m * 16 < u.nvalid) {
#pragma unroll
                for (int bj = 0; bj < 2; ++bj) *(u32x4*)(rowp + bj * HALF) = pack8(acc[ai][bj][m][0], acc[ai][bj][m][1]); } }
    }
};

template <class Epi, class Sched, bool ALIGN_EPI = false, bool SP2 = false, bool GATHER = false>
__device__ __forceinline__ void gemm_phase(PG8_LAS unsigned char* lds, const Gemm g, const Sched& S, const Epi& E) {
    int tid_ = threadIdx.x; asm volatile("" : "+v"(tid_));
    const int tid = tid_, wid = __builtin_amdgcn_readfirstlane(tid >> 6), lane = tid & 63, wr = wid >> 2, wc = wid & 3, fr = lane & 15, fq = lane >> 4;
    const int K = g.K, nt = K / BK;
    static_assert(!GATHER || SP2, "the gathered-A form exists for the SP2 loop only");
    unsigned voffA[2], voffB[2]; int gR[2], gC[2];
#pragma unroll
    for (int i = 0; i < 2; ++i) { int R, C; stage_rc(tid * 16 + i * 8192, R, C); const int Rb = Epi::PERM ? ((R & ~31) + perm32(R & 31)) : R;
        voffA[i] = (unsigned)(R * K + C) * 2u; voffB[i] = (unsigned)(Rb * K + C) * 2u; gR[i] = R; gC[i] = C; }
    unsigned cv0[2] = {0u, 0u}, cv1[2] = {0u, 0u}, nv0[2] = {0u, 0u}, nv1[2] = {0u, 0u};
#define PG8_GVOFF(U, V0, V1) do { _Pragma("unroll") for (int _i = 0; _i < 2; ++_i) { const int _lim = (U).nvalid - 1; const int _j0 = gR[_i] < _lim ? gR[_i] : _lim, _j1 = (gR[_i] + HALF) < _lim ? (gR[_i] + HALF) : _lim; \
        V0[_i] = ((unsigned)(U).gix[_j0] * (unsigned)K + (unsigned)gC[_i]) * 2u; V1[_i] = ((unsigned)(U).gix[_j1] * (unsigned)K + (unsigned)gC[_i]) * 2u; } } while (0)
    const size_t kstep = (size_t)(BK * 2);
    const size_t hstep = (size_t)HALF * K * 2;
    const size_t tstep = 2 * hstep;
    const size_t rowb = (size_t)K * 2;
    const unsigned ldsw = (unsigned)wid * 1024u;
    const int aoff = lds_byte(wr * 64 + fr, fq * 8), boff = lds_byte(wc * 32 + fr, fq * 8);
#define PG8_SA(b, h) (((b) * 2 + (h)) * HTB)
#define PG8_SB(b, h) ((4 + (b) * 2 + (h)) * HTB)
#define PG8_STAGE(bufoff, gbase, voff) do { _Pragma("unroll") for (int _i = 0; _i < 2; ++_i) \
        __builtin_amdgcn_global_load_lds((const unsigned*)((const char*)(gbase) + (voff)[_i]), (PG8_LAS unsigned*)(lds + (bufoff) + ldsw + _i * 8192), 16, 0, 0); } while (0)
#define PG8_STAGE_A(bufoff, gbase, H, V0, V1) do { if constexpr (GATHER) { if (H) PG8_STAGE(bufoff, gbase, V1); else PG8_STAGE(bufoff, gbase, V0); } else { PG8_STAGE(bufoff, (gbase) + (H) * hstep, voffA); } } while (0)
#define PG8_LDA(dst, b, h) do { _Pragma("unroll") for (int m = 0; m < 4; ++m) _Pragma("unroll") for (int k = 0; k < 2; ++k) dst[m][k] = *(const PG8_LAS bf16x8*)(lds + PG8_SA(b, h) + aoff + m * 2048 + k * 1024); } while (0)
#define PG8_LDB(dst, b, h) do { _Pragma("unroll") for (int n = 0; n < 2; ++n) _Pragma("unroll") for (int k = 0; k < 2; ++k) dst[n][k] = *(const PG8_LAS bf16x8*)(lds + PG8_SB(b, h) + boff + n * 2048 + k * 1024); } while (0)
#define PG8_MMA(ai, bj, At, Bt) do { __builtin_amdgcn_s_setprio(1); _Pragma("unroll") for (int m = 0; m < 4; ++m) _Pragma("unroll") for (int n = 0; n < 2; ++n) _Pragma("unroll") for (int k = 0; k < 2; ++k) \
        acc[ai][bj][m][n] = __builtin_amdgcn_mfma_f32_16x16x32_bf16(Bt[n][k], At[m][k], acc[ai][bj][m][n], 0, 0, 0); __builtin_amdgcn_s_setprio(0); } while (0)
#define PG8_WAIT_V(n) asm volatile("s_waitcnt vmcnt(" #n ")" ::: "memory")
#define PG8_WAIT_L(n) asm volatile("s_waitcnt lgkmcnt(" #n ")" ::: "memory")
#define PG8_BAR __builtin_amdgcn_s_barrier()
#define PG8_SCHED __builtin_amdgcn_sched_barrier(0)
    Unit cur, nxt; int ui = 0;
    if (!S.next(0, cur)) return;
    f32x4 acc[2][2][4][2];
#pragma unroll
    for (int a = 0; a < 2; ++a)
#pragma unroll
        for (int b = 0; b < 2; ++b)
#pragma unroll
            for (int m = 0; m < 4; ++m)
#pragma unroll
                for (int n = 0; n < 2; ++n) acc[a][b][m][n] = (f32x4){0.f, 0.f, 0.f, 0.f};
    bf16x8 At[4][2], B0[2][2], B1[2][2];
    const char* cA = GATHER ? (const char*)g.A : (const char*)g.A + (size_t)cur.arow * rowb; const char* cB = (const char*)g.Bt + (size_t)cur.pnb * tstep;
    if constexpr (GATHER) PG8_GVOFF(cur, cv0, cv1);
    S.a_ready(cur);
    if constexpr (SP2) {
        PG8_STAGE(PG8_SB(0, 0), cB, voffB); PG8_STAGE(PG8_SB(0, 1), cB + hstep, voffB); PG8_STAGE_A(PG8_SA(0, 0), cA, 0, cv0, cv1); PG8_STAGE_A(PG8_SA(0, 1), cA, 1, cv0, cv1);
        if (wr == 1) PG8_BAR;
        PG8_WAIT_V(2); PG8_BAR;
        PG8_STAGE(PG8_SB(1, 0), cB + kstep, voffB); PG8_STAGE_A(PG8_SA(1, 0), cA + kstep, 0, cv0, cv1); PG8_STAGE(PG8_SB(1, 1), cB + hstep + kstep, voffB);
        PG8_WAIT_V(6); PG8_BAR;
    } else {
        PG8_STAGE(PG8_SB(0, 0), cB, voffB); PG8_STAGE(PG8_SA(0, 0), cA, voffA); PG8_STAGE(PG8_SB(0, 1), cB + hstep, voffB); PG8_STAGE(PG8_SA(0, 1), cA + hstep, voffA);
        if (wr == 1) PG8_BAR;
        PG8_WAIT_V(4); PG8_BAR;
        PG8_STAGE(PG8_SB(1, 0), cB + kstep, voffB); PG8_STAGE(PG8_SA(1, 0), cA + kstep, voffA); PG8_STAGE(PG8_SB(1, 1), cB + hstep + kstep, voffB);
        PG8_WAIT_V(6); PG8_BAR;
    }
    for (;;) {
        const bool has_next = S.next(ui + 1, nxt);
        const char* nA = GATHER ? cA : (has_next ? (const char*)g.A + (size_t)nxt.arow * rowb : cA); const char* nB = has_next ? (const char*)g.Bt + (size_t)nxt.pnb * tstep : cB;
        if constexpr (GATHER) { if (has_next) PG8_GVOFF(nxt, nv0, nv1); else { nv0[0] = cv0[0]; nv0[1] = cv0[1]; nv1[0] = cv1[0]; nv1[1] = cv1[1]; } }
        for (int t = 0; t < nt; t += 2) {
            const bool last = (t == nt - 2);
            const char* a1 = cA + (size_t)(t + 1) * kstep;
            const char* a2 = last ? nA : cA + (size_t)(t + 2) * kstep; const char* b2 = last ? nB : cB + (size_t)(t + 2) * kstep;
            const char* a3 = a2 + kstep; const char* b3 = b2 + kstep;
            if (last && has_next) S.a_ready(nxt);
            unsigned xv0[2], xv1[2];
            xv0[0] = last ? nv0[0] : cv0[0]; xv0[1] = last ? nv0[1] : cv0[1]; xv1[0] = last ? nv1[0] : cv1[0]; xv1[1] = last ? nv1[1] : cv1[1];
            if constexpr (SP2) {
            PG8_LDB(B0, 0, 0); PG8_LDB(B1, 0, 1); PG8_SCHED; PG8_LDA(At, 0, 0); PG8_STAGE_A(PG8_SA(1, 1), a1, 1, cv0, cv1);
            PG8_WAIT_V(8); PG8_WAIT_L(0); PG8_BAR; PG8_MMA(0, 0, At, B0); PG8_MMA(0, 1, At, B1); PG8_BAR; PG8_SCHED;
            PG8_LDA(At, 0, 1); PG8_STAGE(PG8_SB(0, 0), b2, voffB); PG8_STAGE(PG8_SB(0, 1), b2 + hstep, voffB); PG8_STAGE_A(PG8_SA(0, 0), a2, 0, xv0, xv1);
            PG8_WAIT_V(8); PG8_WAIT_L(0); PG8_BAR; PG8_MMA(1, 0, At, B0); PG8_MMA(1, 1, At, B1); PG8_BAR; PG8_SCHED;
            PG8_LDB(B0, 1, 0); PG8_LDB(B1, 1, 1); PG8_SCHED; PG8_LDA(At, 1, 0); PG8_STAGE_A(PG8_SA(0, 1), a2, 1, xv0, xv1);
            PG8_WAIT_V(8); PG8_WAIT_L(0); PG8_BAR; PG8_MMA(0, 0, At, B0); PG8_MMA(0, 1, At, B1); PG8_BAR; PG8_SCHED;
            PG8_LDA(At, 1, 1); PG8_STAGE(PG8_SB(1, 0), b3, voffB); PG8_STAGE(PG8_SB(1, 1), b3 + hstep, voffB); PG8_STAGE_A(PG8_SA(1, 0), a3, 0, xv0, xv1);
            PG8_WAIT_V(8); PG8_WAIT_L(0); PG8_BAR; PG8_MMA(1, 0, At, B0); PG8_MMA(1, 1, At, B1); PG8_BAR; PG8_SCHED;
            } else {
            PG8_LDB(B0, 0, 0); PG8_SCHED; PG8_LDA(At, 0, 0); PG8_STAGE(PG8_SA(1, 1), a1 + hstep, voffA);
            PG8_WAIT_L(8); PG8_BAR; PG8_WAIT_L(0); PG8_MMA(0, 0, At, B0); PG8_BAR; PG8_SCHED;
            PG8_LDB(B1, 0, 1); PG8_STAGE(PG8_SB(0, 0), b2, voffB);
            PG8_BAR; PG8_WAIT_L(0); PG8_MMA(0, 1, At, B1); PG8_BAR;
            PG8_LDA(At, 0, 1); PG8_STAGE(PG8_SA(0, 0), a2, voffA);
            PG8_BAR; PG8_WAIT_L(0); PG8_MMA(1, 0, At, B0); PG8_BAR; PG8_SCHED;
            PG8_STAGE(PG8_SB(0, 1), b2 + hstep, voffB);
            PG8_WAIT_V(6); PG8_BAR; PG8_MMA(1, 1, At, B1); PG8_BAR;
            PG8_LDB(B0, 1, 0); PG8_SCHED; PG8_LDA(At, 1, 0); PG8_STAGE(PG8_SA(0, 1), a2 + hstep, voffA);
            PG8_WAIT_L(8); PG8_BAR; PG8_WAIT_L(0); PG8_MMA(0, 0, At, B0); PG8_BAR; PG8_SCHED;
            PG8_LDB(B1, 1, 1); PG8_STAGE(PG8_SB(1, 0), b3, voffB);
            PG8_BAR; PG8_WAIT_L(0); PG8_MMA(0, 1, At, B1); PG8_BAR;
            PG8_LDA(At, 1, 1); PG8_STAGE(PG8_SA(1, 0), a3, voffA);
            PG8_BAR; PG8_WAIT_L(0); PG8_MMA(1, 0, At, B0); PG8_BAR; PG8_SCHED;
            PG8_STAGE(PG8_SB(1, 1), b3 + hstep, voffB);
            PG8_WAIT_V(6); PG8_BAR; PG8_MMA(1, 1, At, B1); PG8_BAR;
            }
        }
        if constexpr (ALIGN_EPI) { if (wr == 0) PG8_BAR; }
        if constexpr (!Epi::AFTER_DRAIN) { E(acc, cur, wr, wc, fr, fq); S.done(cur); }
        if (!has_next) break;
#pragma unroll
        for (int a = 0; a < 2; ++a)
#pragma unroll
            for (int b = 0; b < 2; ++b)
#pragma unroll
                for (int m = 0; m < 4; ++m)
#pragma unroll
                    for (int n = 0; n < 2; ++n) acc[a][b][m][n] = (f32x4){0.f, 0.f, 0.f, 0.f};
        cur = nxt; cA = nA; cB = nB; ++ui; cv0[0] = nv0[0]; cv0[1] = nv0[1]; cv1[0] = nv1[0]; cv1[1] = nv1[1];
        if constexpr (ALIGN_EPI) { if (wr == 1) PG8_BAR; }
    }
    PG8_WAIT_V(0);
    if constexpr (!ALIGN_EPI) { if (wr == 0) PG8_BAR; }
    PG8_BAR;
    if constexpr (Epi::AFTER_DRAIN) { E.fused(acc, cur, wr, wc, fr, fq, lds, wid, lane); S.done(cur); }
#undef PG8_SA
#undef PG8_SB
#undef PG8_STAGE
#undef PG8_STAGE_A
#undef PG8_GVOFF
#undef PG8_LDA
#undef PG8_LDB
#undef PG8_MMA
#undef PG8_WAIT_V
#undef PG8_WAIT_L
#undef PG8_BAR
#undef PG8_SCHED
}
}
#define GAS __attribute__((address_space(1)))
#define LAS __attribute__((address_space(3)))
typedef unsigned short bf16;
typedef unsigned v4u __attribute__((ext_vector_type(4)));
typedef float f32x4 __attribute__((ext_vector_type(4)));
typedef short bf16x8 __attribute__((ext_vector_type(8)));
typedef GAS unsigned gu32;
typedef GAS unsigned long long gu64;
#define RLX_AGENT __ATOMIC_RELAXED, __HIP_MEMORY_SCOPE_AGENT
#define LDS_WAIT() asm volatile("s_waitcnt lgkmcnt(0)" ::: "memory")
#define VM_WAIT() asm volatile("s_waitcnt vmcnt(0)" ::: "memory")
__device__ __forceinline__ unsigned long long rt() { return __builtin_amdgcn_s_memrealtime(); }
__device__ __forceinline__ unsigned f2bf(float f) { unsigned u = __builtin_bit_cast(unsigned, f); return (u + 0x7fffu + ((u >> 16) & 1u)) >> 16; }
__device__ __forceinline__ unsigned pk2(float lo, float hi) { return f2bf(lo) | (f2bf(hi) << 16); }
#define XB_TMO      128
#define XB_XCNT(j)  (256  + 64 * (j))
#define XB_XSUB(j)  (1280 + 64 * (j))
#define XB_XGEN(j)  (2304 + 64 * (j))
#define XB_TOP      3328
#define XB_TOPGEN   3392
#define XCD_BAR_WORDS 3456
#define XB_SPIN_CAP (1u << 18)

__device__ __forceinline__ unsigned xb_ld(unsigned* p)              { return __hip_atomic_load(p, __ATOMIC_RELAXED, __HIP_MEMORY_SCOPE_AGENT); }
__device__ __forceinline__ unsigned xb_add(unsigned* p, unsigned v) { return __hip_atomic_fetch_add(p, v, __ATOMIC_RELAXED, __HIP_MEMORY_SCOPE_AGENT); }
__device__ __forceinline__ unsigned xb_xcc_id() { return (unsigned)__builtin_amdgcn_s_getreg((3 << 11) | 20) & 0xFu; }
#define XB_SPIN(cond, bar) do { unsigned _sp = 0; while (cond) { __builtin_amdgcn_s_sleep(1); \
    if ((++_sp & 255u) == 0u) { if (xb_ld(&(bar)[XB_TMO])) break; if (_sp > XB_SPIN_CAP) { atomicAdd(&(bar)[XB_TMO], 1u); break; } } } } while (0)

struct XcdBarrier {
    unsigned* bar; unsigned x;
    volatile LAS unsigned* st;
};

__device__ __forceinline__ XcdBarrier xcd_barrier_post(unsigned* bar, volatile LAS unsigned* st) {
    XcdBarrier b; b.bar = bar; b.x = xb_xcc_id(); b.st = st;
    if (threadIdx.x == 0) (void)xb_add(&bar[XB_XCNT(b.x)], 1u);
    return b;
}
__device__ __forceinline__ void xcd_barrier_complete(unsigned* bar, unsigned x, unsigned& nloc, unsigned& nx) {
    const unsigned G = gridDim.x * gridDim.y * gridDim.z;
    unsigned sum, cnt, mine, sp = 0u;
    for (;;) {
        sum = 0u; cnt = 0u; mine = 0u;
#pragma unroll
        for (unsigned j = 0; j < 16; ++j) { const unsigned c = xb_ld(&bar[XB_XCNT(j)]); sum += c; cnt += (c > 0u) ? 1u : 0u; mine = (j == x) ? c : mine; }
        if (sum == G) break;
        __builtin_amdgcn_s_sleep(1);
        if ((++sp & 255u) == 0u) { if (xb_ld(&bar[XB_TMO])) break; if (sp > XB_SPIN_CAP) { atomicAdd(&bar[XB_TMO], 1u); break; } }
    }
    nloc = mine > 0u ? mine : 1u; nx = cnt > 0u ? cnt : 1u;
}

__device__ __forceinline__ void xcd_barrier(const XcdBarrier& b) {
    asm volatile("s_waitcnt vmcnt(0)" ::: "memory");
    __syncthreads();
    if (threadIdx.x == 0) {
        unsigned* bar = b.bar;
        __builtin_amdgcn_s_waitcnt(0);
        unsigned nloc = b.st[0], nx = b.st[1];
        if (nloc == 0u) { xcd_barrier_complete(bar, b.x, nloc, nx); b.st[0] = nloc; b.st[1] = nx; }
        const unsigned old = xb_add(&bar[XB_XSUB(b.x)], 1u);
        const unsigned gen = old / nloc;
        if (old + 1u == (gen + 1u) * nloc) {
            __builtin_amdgcn_fence(__ATOMIC_RELEASE, "agent");
            asm volatile("s_waitcnt vmcnt(0)" ::: "memory");
            const unsigned og = xb_add(&bar[XB_TOP], 1u);
            const unsigned tg = og / nx;
            if (og + 1u == (tg + 1u) * nx) xb_add(&bar[XB_TOPGEN], 1u);
            else XB_SPIN(xb_ld(&bar[XB_TOPGEN]) == tg, bar);
            __builtin_amdgcn_fence(__ATOMIC_ACQUIRE, "agent");
            xb_add(&bar[XB_XGEN(b.x)], 1u);
            asm volatile("s_waitcnt vmcnt(0)" ::: "memory");
        } else {
            XB_SPIN(xb_ld(&bar[XB_XGEN(b.x)]) == gen, bar);
            __builtin_amdgcn_fence(__ATOMIC_ACQUIRE, "agent");
            asm volatile("s_waitcnt vmcnt(0)" ::: "memory");
        }
    }
    __syncthreads();
}

constexpr int NWAVES = 8;
constexpr int BATCH = 8, SEQ = 2048, NMETA = 16, D = 1024;
constexpr int MR = BATCH * SEQ;
constexpr int MT = MR + BATCH * NMETA;
constexpr int M = 16640;
constexpr int INW = 3840, DFF = 2816, NEXP = 8, DEXP = 1408;
constexpr float ALPHA = 1.4142135623730951f;
constexpr float LN_EPS = 1e-5f;

constexpr size_t MiB = 1u << 20;
constexpr size_t WS_CTL = 0, CTL_ZERO_BYTES = 64 * 1024;
constexpr size_t WS_TOKE = 256 * 1024, WS_E12 = 768 * 1024, WS_SL1 = 832 * 1024, WS_SL2 = 896 * 1024, WS_G1 = 960 * 1024;
constexpr int CW_CNT = 8192;
constexpr size_t WS_W = 1 * MiB;
constexpr size_t WS_WIN = WS_W, WS_WAP = WS_W + 15 * MiB / 2, WS_WCP = WS_WAP + MiB, WS_WOUT = WS_WCP + MiB, WS_WGU = WS_WOUT + 2 * MiB, WS_WD = WS_WGU + 44 * MiB;
constexpr size_t AB = 79 * MiB;
constexpr size_t R1024 = (size_t)M * 1024 * 2, R512 = (size_t)M * 512 * 2, R128 = (size_t)M * 128 * 2;
constexpr size_t WS_H = AB, WS_Q = WS_H + R1024, WS_SGA = WS_Q + R512, WS_K = WS_SGA + R1024, WS_V = WS_K + R128, WS_GLU = WS_V + R128, WS_SGC = WS_GLU + R512, WS_CO = WS_SGC + R1024;
constexpr size_t WS_ACT = WS_Q;
constexpr size_t WS_Z = AB + 122 * MiB;
constexpr size_t WS_OUTS = WS_Z;
constexpr int MOE_TAB_OFF = 131072 + 1024;
constexpr size_t WS_END = WS_Z + (size_t)M * 1024 * 4;
static_assert(WS_WD + 22 * MiB <= AB && WS_CO + R512 <= WS_END && WS_ACT + (size_t)M * DFF * 2 <= WS_Z && WS_END <= 272 * MiB, "ws map");
constexpr int CW_BAR = 4096;

constexpr int RING_BYTES = 131072, LDSCTL_OFF = RING_BYTES, MISC_OFF = LDSCTL_OFF + 320, LDS_BYTES = 147456;

__device__ __forceinline__ float wave_sum(float v) {
#pragma unroll
    for (int o = 1; o < 64; o <<= 1) v += __shfl_xor(v, o);
    return v;
}
__device__ __forceinline__ float wave_max(float v) {
#pragma unroll
    for (int o = 1; o < 64; o <<= 1) v = fmaxf(v, __shfl_xor(v, o));
    return v;
}
__device__ __forceinline__ float bfl(unsigned w) { return __builtin_bit_cast(float, w << 16); }
__device__ __forceinline__ float bfh(unsigned w) { return __builtin_bit_cast(float, w & 0xffff0000u); }
__device__ __forceinline__ float sigmoid_f(float x) { return 1.0f / (1.0f + __expf(-x)); }

__device__ __forceinline__ int winmap(int n) { return n < 768 ? n : (n < 1280 ? 768 + 2 * (n - 768) : (n < 1792 ? 769 + 2 * (n - 1280) : n)); }
__device__ __forceinline__ void transpose_item(const float* W, int K, int N, bf16* WT, int mode, int roff, LAS float* scr, int item, int lane) {
    const int nblk = N / 32, kb = item / nblk, nb = item % nblk, k0 = 64 * kb, n0 = 32 * nb;
#pragma unroll 8
    for (int i = 0; i < 32; ++i) { const int kk = 2 * i + (lane >> 5); scr[kk * 33 + (lane & 31)] = W[(size_t)(k0 + kk) * N + n0 + (lane & 31)]; }
    LDS_WAIT(); asm volatile("" ::: "memory");
    const int c = lane & 7;
#pragma unroll
    for (int j = 0; j < 4; ++j) { const int n = (lane >> 3) + 8 * j; const LAS float* s = scr + (8 * c) * 33 + n;
        v4u o; o.x = pk2(s[0 * 33], s[1 * 33]); o.y = pk2(s[2 * 33], s[3 * 33]); o.z = pk2(s[4 * 33], s[5 * 33]); o.w = pk2(s[6 * 33], s[7 * 33]);
        const int nn = n0 + n, drow = mode == 0 ? roff + nn : (mode == 1 ? roff + 2 * nn : winmap(nn));
        *(GAS v4u*)(WT + (size_t)drow * K + k0 + 8 * c) = o; }
    LDS_WAIT(); asm volatile("" ::: "memory");
}
struct Args { const float* in[25]; float* out; unsigned char* ws; };
typedef __attribute__((address_space(4))) const Args CArgs;

__device__ __forceinline__ void convert_weights(CArgs* ap, int l, LAS float* scr, int gw, int NGW, int lane_in) {
    int lane = lane_in; asm volatile("" : "+v"(lane));
    unsigned char* ws = ap->ws;
    const int nC = 1920 + 256 + 256 + 512;
    const int total = nC + (l == 0 ? 3 * 1408 : 24 * 704);
    for (int it = gw; it < total; it += NGW) {
        const float* src; bf16* dst; int K, N, mode, roff, li;
        if (it < 1920) { src = ap->in[5] + (size_t)l * 1024 * INW; K = 1024; N = INW; dst = (bf16*)(ws + WS_WIN); mode = 2; roff = 0; li = it; }
        else if (it < 2176) { src = ap->in[11] + (size_t)l * 512 * 1024; K = 512; N = 1024; dst = (bf16*)(ws + WS_WAP); mode = 0; roff = 0; li = it - 1920; }
        else if (it < 2432) { src = ap->in[12] + (size_t)l * 512 * 1024; K = 512; N = 1024; dst = (bf16*)(ws + WS_WCP); mode = 0; roff = 0; li = it - 2176; }
        else if (it < 2944) { src = ap->in[13] + (size_t)l * 1024 * 1024; K = 1024; N = 1024; dst = (bf16*)(ws + WS_WOUT); mode = 0; roff = 0; li = it - 2432; }
        else if (l == 0) { const int r = it - nC, j = r / 1408; li = r % 1408;
            if (j == 0) { src = ap->in[16]; K = 1024; N = DFF; dst = (bf16*)(ws + WS_WGU); mode = 1; roff = 0; }
            else if (j == 1) { src = ap->in[17]; K = 1024; N = DFF; dst = (bf16*)(ws + WS_WGU); mode = 1; roff = 1; }
            else { src = ap->in[18]; K = DFF; N = 1024; dst = (bf16*)(ws + WS_WD); mode = 0; roff = 0; } }
        else { const int r = it - nC, j = r / 704, e = j / 3, kind = j % 3; li = r % 704;
            if (kind == 0) { src = ap->in[20] + (size_t)e * 1024 * DEXP; K = 1024; N = DEXP; dst = (bf16*)(ws + WS_WGU) + (size_t)e * 2 * DEXP * 1024; mode = 1; roff = 0; }
            else if (kind == 1) { src = ap->in[21] + (size_t)e * 1024 * DEXP; K = 1024; N = DEXP; dst = (bf16*)(ws + WS_WGU) + (size_t)e * 2 * DEXP * 1024; mode = 1; roff = 1; }
            else { src = ap->in[22] + (size_t)e * DEXP * 1024; K = DEXP; N = 1024; dst = (bf16*)(ws + WS_WD) + (size_t)e * 1024 * DEXP; mode = 0; roff = 0; } }
        transpose_item(src, K, N, dst, mode, roff, scr, li, lane);
    }
}

__device__ __forceinline__ void ln_row(const float* src, const float* g, const float* b, int lane, f32x4 (&v)[4]) {
    const GAS f32x4* xr = (const GAS f32x4*)src + lane;
    float s = 0.f;
#pragma unroll
    for (int j = 0; j < 4; ++j) { v[j] = xr[64 * j]; s += (v[j].x + v[j].y) + (v[j].z + v[j].w); }
    const float mean = wave_sum(s) * (1.f / 1024.f); float s2 = 0.f;
#pragma unroll
    for (int j = 0; j < 4; ++j) { v[j] = v[j] - mean; s2 += (v[j].x * v[j].x + v[j].y * v[j].y) + (v[j].z * v[j].z + v[j].w * v[j].w); }
    const float rstd = 1.f / sqrtf(wave_sum(s2) * (1.f / 1024.f) + LN_EPS);
#pragma unroll
    for (int j = 0; j < 4; ++j) { const f32x4 gg = ((const GAS f32x4*)g)[lane + 64 * j], bb = ((const GAS f32x4*)b)[lane + 64 * j]; v[j] = v[j] * rstd * gg + bb; }
}
__device__ __forceinline__ void store_row_bf16(bf16* dst, int lane, const f32x4 (&v)[4]) {
    GAS unsigned long long* o8 = (GAS unsigned long long*)dst + lane;
#pragma unroll
    for (int j = 0; j < 4; ++j) o8[64 * j] = (unsigned long long)pk2(v[j].x, v[j].y) | ((unsigned long long)pk2(v[j].z, v[j].w) << 32);
}
__device__ __forceinline__ void embed_phase(CArgs* ap, bf16* H, int gw, int NGW, int lane_in) {
    int lane = lane_in; asm volatile("" : "+v"(lane));
    for (int r = gw; r < M; r += NGW) {
        f32x4 v[4];
        if (r >= MT) {
#pragma unroll
            for (int j = 0; j < 4; ++j) v[j] = (f32x4){0.f, 0.f, 0.f, 0.f};
        } else {
            const float* src = r < MR ? ap->in[0] + (size_t)r * D : ap->in[1] + (size_t)((r - MR) & 15) * D;
            ln_row(src, ap->in[2], ap->in[3], lane, v);
        }
        store_row_bf16(H + (size_t)r * D, lane, v);
    }
}
__device__ __forceinline__ void ln_phase_bf16(const float* Z, const float* g, const float* b, bf16* H, const float* router, float* CW, int gw, int NGW, int lane_in) {
    int lane = lane_in; asm volatile("" : "+v"(lane));
    for (int r = gw; r < M; r += NGW) {
        f32x4 v[4]; ln_row(Z + (size_t)r * D, g, b, lane, v);
        store_row_bf16(H + (size_t)r * D, lane, v);
        if (router) {
            float lg[8];
#pragma unroll
            for (int e = 0; e < 8; ++e) lg[e] = 0.f;
#pragma unroll
            for (int j = 0; j < 4; ++j)
#pragma unroll
                for (int i = 0; i < 4; ++i) { const int col = 256 * j + 4 * lane + i; const f32x4 r0 = *(const GAS f32x4*)(router + (size_t)col * 8), r1 = *(const GAS f32x4*)(router + (size_t)col * 8 + 4); const float x = v[j][i];
                    lg[0] += x * r0.x; lg[1] += x * r0.y; lg[2] += x * r0.z; lg[3] += x * r0.w; lg[4] += x * r1.x; lg[5] += x * r1.y; lg[6] += x * r1.z; lg[7] += x * r1.w; }
#pragma unroll
            for (int e = 0; e < 8; ++e) lg[e] = wave_sum(lg[e]);
            int i1 = 0; float v1 = lg[0];
#pragma unroll
            for (int e = 1; e < 8; ++e) if (lg[e] > v1) { v1 = lg[e]; i1 = e; }
            int i2 = -1; float v2 = -INFINITY;
#pragma unroll
            for (int e = 0; e < 8; ++e) if (e != i1 && lg[e] > v2) { v2 = lg[e]; i2 = e; }
            const float g1 = 1.0f / (1.0f + __expf(v2 - v1)), g2 = 1.0f - g1;
            if (lane < 8) CW[(size_t)lane * M + r] = lane == i1 ? g1 : (lane == i2 ? g2 : 0.f);
        }
    }
}
__device__ __forceinline__ void ln_phase_out(const float* Z, const float* g, const float* b, float* out, int gw, int NGW, int lane_in) {
    int lane = lane_in; asm volatile("" : "+v"(lane));
    for (int r = gw; r < MR; r += NGW) {
        f32x4 v[4]; ln_row(Z + (size_t)r * D, g, b, lane, v);
        GAS f32x4* o = (GAS f32x4*)(out + (size_t)r * D) + lane;
#pragma unroll
        for (int j = 0; j < 4; ++j) o[64 * j] = v[j];
    }
}

__device__ __forceinline__ int rel_bucket(int n) {
    if (n < 16) return n;
    int b = 16; b += n >= 19; b += n >= 21; b += n >= 24; b += n >= 27; b += n >= 31; b += n >= 35; b += n >= 40; b += n >= 46; b += n >= 52; b += n >= 59; b += n >= 67; b += n >= 77; b += n >= 87; b += n >= 99; b += n >= 113;
    return b;
}
__device__ __forceinline__ void attn_naive_phase(const bf16* Q, const bf16* Kb, const bf16* Vb, bf16* AO, const float* rel_bias, const float* sinks, LAS float* pl, int row_lo, int row_hi, int gw, int NGW, int lane_in) {
    int lane = lane_in; asm volatile("" : "+v"(lane));
    for (int it = gw; it < (row_hi - row_lo) * 8; it += NGW) {
        const int row = row_lo + (it >> 3), hq = it & 7, hkv = hq >> 2;
        int b, pos, s, nmeta, band_lo, nband;
        if (row < MR) { b = row >> 11; s = row & 2047; pos = 16 + s; nmeta = 16; band_lo = s - 127 < 0 ? 0 : s - 127; nband = s - band_lo + 1; }
        else { const int mi = row - MR; b = mi >> 4; pos = mi & 15; s = 0; nmeta = pos + 1; band_lo = 0; nband = 0; }
        const int nkeys = nmeta + nband;
        unsigned qw[32];
        { const GAS v4u* qp = (const GAS v4u*)(Q + (size_t)row * 512 + hq * 64);
#pragma unroll
          for (int i = 0; i < 8; ++i) { const v4u t = qp[i]; qw[4 * i] = t.x; qw[4 * i + 1] = t.y; qw[4 * i + 2] = t.z; qw[4 * i + 3] = t.w; } }
        const float sink = sinks[hq];
        float sc[3]; float mx = -INFINITY;
#pragma unroll
        for (int c = 0; c < 3; ++c) {
            const int j = c * 64 + lane; const bool valid = j < nkeys;
            const int jj = valid ? j : 0;
            const int krow = jj < nmeta ? MR + b * 16 + jj : b * 2048 + band_lo + (jj - nmeta);
            const int dist = jj < nmeta ? pos - jj : s - (band_lo + jj - nmeta);
            const GAS v4u* kp = (const GAS v4u*)(Kb + (size_t)krow * 128 + hkv * 64);
            float dot = 0.f;
#pragma unroll
            for (int i = 0; i < 8; ++i) { const v4u t = kp[i];
                dot += bfl(qw[4 * i]) * bfl(t.x) + bfh(qw[4 * i]) * bfh(t.x) + bfl(qw[4 * i + 1]) * bfl(t.y) + bfh(qw[4 * i + 1]) * bfh(t.y)
                     + bfl(qw[4 * i + 2]) * bfl(t.z) + bfh(qw[4 * i + 2]) * bfh(t.z) + bfl(qw[4 * i + 3]) * bfl(t.w) + bfh(qw[4 * i + 3]) * bfh(t.w); }
            sc[c] = valid ? dot * 0.125f + rel_bias[rel_bucket(dist) * 8 + hq] : -INFINITY;
            mx = fmaxf(mx, sc[c]);
        }
        mx = fmaxf(wave_max(mx), sink);
        float ps = 0.f;
#pragma unroll
        for (int c = 0; c < 3; ++c) { const float p = __expf(sc[c] - mx); ps += p; pl[c * 64 + lane] = p; }
        const float denom = wave_sum(ps) + __expf(sink - mx);
        LDS_WAIT(); asm volatile("" ::: "memory");
        float o = 0.f;
#pragma unroll 8
        for (int j = 0; j < nkeys; ++j) {
            const int krow = j < nmeta ? MR + b * 16 + j : b * 2048 + band_lo + (j - nmeta);
            o += pl[j] * bfl((unsigned)Vb[(size_t)krow * 128 + hkv * 64 + lane]);
        }
        LDS_WAIT(); asm volatile("" ::: "memory");
        AO[(size_t)row * 512 + hq * 64 + lane] = (bf16)f2bf(o / denom);
    }
}

namespace att {
typedef short bf16x8 __attribute__((ext_vector_type(8)));
typedef short s16x4 __attribute__((ext_vector_type(4)));
typedef float f32x16 __attribute__((ext_vector_type(16)));
typedef float f32x2_t __attribute__((ext_vector_type(2))); typedef __bf16 bf16x2_t __attribute__((ext_vector_type(2)));
constexpr int NK = 288, NG = 18;
constexpr int LK = 0, LV = NK * 128, LBIAS = 2 * NK * 128, LWS = LBIAS + 2048, LOST = LWS + 2048, LEND = LOST + 32768;
__device__ __forceinline__ int crow(int r, int hi) { return (r & 3) + 8 * (r >> 2) + 4 * hi; }
__device__ __forceinline__ unsigned cvtpk_s(float lo, float hi) { f32x2_t v = {lo, hi}; bf16x2_t b = __builtin_convertvector(v, bf16x2_t); return __builtin_bit_cast(unsigned, b); }
typedef __attribute__((address_space(3))) const char* lds_cptr;
typedef short v4i16_t __attribute__((ext_vector_type(4)));
__device__ __forceinline__ s16x4 vtr(lds_cptr p) { return __builtin_bit_cast(s16x4, __builtin_amdgcn_ds_read_tr16_b64_v4i16((__attribute__((address_space(3))) v4i16_t*)p)); }

__device__ __forceinline__ void attn_unit(int b, int n, int hkv, const bf16* Q, const bf16* Kg, const bf16* Vg, bf16* AO, const float* relb, const float* sinks, LAS unsigned char* L) {
    int tid_ = threadIdx.x; asm volatile("" : "+v"(tid_));
    const int tid = tid_, lane = tid & 63, r32 = lane & 31, hi = lane >> 5; const int wid = __builtin_amdgcn_readfirstlane(tid >> 6);
    { const int g = tid >> 7, dist = tid & 127; ((LAS float*)(L + LBIAS))[tid] = relb[rel_bucket(dist) * 8 + hkv * 4 + g]; }
    for (int idx = tid; idx < NK * 8; idx += 512) {
        const int key = idx >> 3, c = idx & 7; int row = -1;
        if (key < 16) row = MR + b * 16 + key;
        else if (key >= 32) { const int sp = (n - 1) * 128 + (key - 32); if (sp >= 0) row = b * 2048 + sp; }
        v4u kv = (v4u){0u, 0u, 0u, 0u}, vv = (v4u){0u, 0u, 0u, 0u};
        if (row >= 0) { kv = *(const GAS v4u*)(Kg + (size_t)row * 128 + hkv * 64 + c * 8); vv = *(const GAS v4u*)(Vg + (size_t)row * 128 + hkv * 64 + c * 8); }
        *(LAS v4u*)(L + LK + c * (NK * 16) + key * 16) = kv;
        *(LAS v4u*)(L + LV + ((c >> 2) * NG + (key >> 4)) * 1024 + (key & 15) * 64 + (c & 3) * 16) = vv;
    }
    __syncthreads();
    const int g = wid >> 1, qh = wid & 1, hq = hkv * 4 + g;
    const float sink = sinks[hq];
    const LAS float* biasT = (const LAS float*)(L + LBIAS) + g * 128;
    LAS float* wsf = (LAS float*)(L + LWS) + wid * 64;
    LAS bf16* stg = (LAS bf16*)(L + LOST) + wid * 2048;
    const int voff = ((lane >> 4) & 1) * 32 + (lane & 3) * 8 + (4 * hi + ((lane & 15) >> 2)) * 64;
    for (int sb = 0; sb < 2; ++sb) {
        const int a0 = 64 * qh + 32 * sb, a = a0 + r32, t0 = a0 >> 5;
        const size_t qrow = (size_t)b * 2048 + n * 128 + a;
        bf16x8 qr[4];
#pragma unroll
        for (int d0 = 0; d0 < 4; ++d0) qr[d0] = *(const GAS bf16x8*)(Q + qrow * 512 + hq * 64 + d0 * 16 + hi * 8);
        f32x16 S[6];
#pragma unroll
        for (int jt = 0; jt < 6; ++jt) { const int kt = jt == 0 ? 0 : t0 + jt; f32x16 acc = {};
#pragma unroll
            for (int d0 = 0; d0 < 4; ++d0) { const bf16x8 kf = *(const LAS bf16x8*)(L + LK + (d0 * 2 + hi) * (NK * 16) + (kt * 32 + r32) * 16); acc = __builtin_amdgcn_mfma_f32_32x32x16_bf16(kf, qr[d0], acc, 0, 0, 0); }
            S[jt] = acc; }
        const int posq = 16 + n * 128 + a; float mx = -INFINITY;
#pragma unroll
        for (int r = 0; r < 16; ++r) { const int m = crow(r, hi); const bool valid = m < 16; const int dist = posq - m; const int di = valid ? (dist > 127 ? 127 : dist) : 0;
            const float bs = biasT[di]; const float v = valid ? S[0][r] * 0.125f + bs : -INFINITY; S[0][r] = v; mx = fmaxf(mx, v); }
#pragma unroll
        for (int jt = 1; jt < 6; ++jt)
#pragma unroll
            for (int r = 0; r < 16; ++r) { const int kk = 32 * (t0 + jt - 1) + crow(r, hi); const int dist = 128 + a - kk; const bool valid = dist >= 0 && dist < 128 && (n > 0 || kk >= 128);
                const float bs = biasT[valid ? dist : 0]; const float v = valid ? S[jt][r] * 0.125f + bs : -INFINITY; S[jt][r] = v; mx = fmaxf(mx, v); }
        mx = fmaxf(mx, __shfl_xor(mx, 32)); const float mrow = fmaxf(mx, sink);
        float l = 0.f;
#pragma unroll
        for (int jt = 0; jt < 6; ++jt)
#pragma unroll
            for (int r = 0; r < 16; ++r) { const float p = __expf(S[jt][r] - mrow); S[jt][r] = p; l += p; }
        l += __shfl_xor(l, 32); l += __expf(sink - mrow);
        f32x16 o[2]; o[0] = f32x16{}; o[1] = f32x16{};
#pragma unroll
        for (int jt = 0; jt < 6; ++jt) { const int kt = jt == 0 ? 0 : t0 + jt;
#pragma unroll
            for (int h2 = 0; h2 < 2; ++h2) { v4u pw; pw.x = cvtpk_s(S[jt][8 * h2 + 0], S[jt][8 * h2 + 1]); pw.y = cvtpk_s(S[jt][8 * h2 + 2], S[jt][8 * h2 + 3]); pw.z = cvtpk_s(S[jt][8 * h2 + 4], S[jt][8 * h2 + 5]); pw.w = cvtpk_s(S[jt][8 * h2 + 6], S[jt][8 * h2 + 7]);
                const bf16x8 pa = __builtin_bit_cast(bf16x8, pw); const int grp = 2 * kt + h2;
#pragma unroll
                for (int dh = 0; dh < 2; ++dh) { const lds_cptr vp = (lds_cptr)(L + LV + (dh * NG + grp) * 1024 + voff); const s16x4 lo = vtr(vp), hh = vtr(vp + 512);
                    const bf16x8 vf = (bf16x8){lo[0], lo[1], lo[2], lo[3], hh[0], hh[1], hh[2], hh[3]}; o[dh] = __builtin_amdgcn_mfma_f32_32x32x16_bf16(pa, vf, o[dh], 0, 0, 0); } } }
        if (hi == 0) wsf[r32] = l;
        LDS_WAIT(); asm volatile("" ::: "memory");
#pragma unroll
        for (int r = 0; r < 16; ++r) { const int q = crow(r, hi); const float rl = 1.0f / wsf[q];
#pragma unroll
            for (int dh = 0; dh < 2; ++dh) stg[q * 64 + dh * 32 + r32] = (bf16)f2bf(o[dh][r] * rl); }
        LDS_WAIT(); asm volatile("" ::: "memory");
#pragma unroll
        for (int i = 0; i < 4; ++i) { const int row = i * 8 + (lane >> 3), ch = lane & 7; const v4u v = *(const LAS v4u*)(stg + row * 64 + ch * 8);
            *(GAS v4u*)(AO + ((size_t)b * 2048 + n * 128 + a0 + row) * 512 + hq * 64 + ch * 8) = v; }
        LDS_WAIT(); asm volatile("" ::: "memory");
    }
    __syncthreads();
}
}

__device__ __forceinline__ void conv_naive_phase(const bf16* GLU, bf16* CO, const float* dw, const float* db, const float* lg, const float* lb, int row_lo, int gw, int NGW, int lane_in) {
    int lane = lane_in; asm volatile("" : "+v"(lane));
    for (int row = row_lo + gw; row < M; row += NGW) {
        if (row >= MT) { *(GAS v4u*)(CO + (size_t)row * 512 + 8 * lane) = (v4u){0u, 0u, 0u, 0u}; continue; }
        int b, pos;
        if (row < MR) { b = row >> 11; pos = 16 + (row & 2047); } else { const int mi = row - MR; b = mi >> 4; pos = mi & 15; }
        float acc[8];
        { const f32x4 b0 = *(const GAS f32x4*)(db + 8 * lane), b1 = *(const GAS f32x4*)(db + 8 * lane + 4); acc[0] = b0.x; acc[1] = b0.y; acc[2] = b0.z; acc[3] = b0.w; acc[4] = b1.x; acc[5] = b1.y; acc[6] = b1.z; acc[7] = b1.w; }
        for (int j = 0; j < 31; ++j) {
            const int p = pos - 30 + j; if (p < 0) continue;
            const int r2 = p < 16 ? MR + b * 16 + p : b * 2048 + p - 16;
            const v4u t = *(const GAS v4u*)(GLU + (size_t)r2 * 512 + 8 * lane);
            const f32x4 w0 = *(const GAS f32x4*)(dw + (size_t)j * 512 + 8 * lane), w1 = *(const GAS f32x4*)(dw + (size_t)j * 512 + 8 * lane + 4);
            acc[0] += bfl(t.x) * w0.x; acc[1] += bfh(t.x) * w0.y; acc[2] += bfl(t.y) * w0.z; acc[3] += bfh(t.y) * w0.w;
            acc[4] += bfl(t.z) * w1.x; acc[5] += bfh(t.z) * w1.y; acc[6] += bfl(t.w) * w1.z; acc[7] += bfh(t.w) * w1.w;
        }
        float s = 0.f;
#pragma unroll
        for (int i = 0; i < 8; ++i) s += acc[i];
        const float mean = wave_sum(s) * (1.f / 512.f); float s2 = 0.f;
#pragma unroll
        for (int i = 0; i < 8; ++i) { acc[i] -= mean; s2 += acc[i] * acc[i]; }
        const float rstd = 1.f / sqrtf(wave_sum(s2) * (1.f / 512.f) + LN_EPS);
        float y[8];
#pragma unroll
        for (int i = 0; i < 8; ++i) { const float t = acc[i] * rstd * lg[8 * lane + i] + lb[8 * lane + i]; y[i] = t * sigmoid_f(t); }
        v4u o; o.x = pk2(y[0], y[1]); o.y = pk2(y[2], y[3]); o.z = pk2(y[4], y[5]); o.w = pk2(y[6], y[7]);
        *(GAS v4u*)(CO + (size_t)row * 512 + 8 * lane) = o;
    }
}


struct MoeOrder {
    int G, c, nU, ncol; const LAS int* tab; const int* tokE;
    __device__ __forceinline__ bool next(int i, pg8::Unit& u) const {
        const int Lx = i * G + c; if (Lx >= nU) return false;
        int wgid; { const int q = nU / 8, r = nU % 8, xcd = Lx % 8, off = Lx / 8; wgid = (xcd < r ? xcd * (q + 1) : r * (q + 1) + (xcd - r) * q) + off; }
        int e = 0, rem = wgid;
        for (; e < 7; ++e) { const int ue = tab[e] * ncol; if (rem < ue) break; rem -= ue; }
        const int nt = tab[e], pml = rem % nt, pn = rem / nt, left = tab[16 + e] - 256 * pml;
        u.pm = 0; u.pn = pn; u.pnb = e * ncol + pn; u.orow = tab[8 + e] + 256 * pml; u.arow = u.orow; u.nvalid = left < 256 ? left : 256; u.gix = tokE ? tokE + e * 16384 + 256 * pml : nullptr; return true;
    }
    __device__ __forceinline__ void a_ready(const pg8::Unit&) const {}
    __device__ __forceinline__ void done(const pg8::Unit&) const {}
};
__device__ __forceinline__ void moe_tables(const unsigned* cnt, LAS int* tab) {
    if (threadIdx.x == 0) { int run = 0, tot = 0;
        for (int e = 0; e < 8; ++e) { const int c = (int)cnt[e]; tab[16 + e] = c; tab[8 + e] = run; run += c; const int nt = (c + 255) >> 8; tab[e] = nt; tot += nt; }
        tab[24] = tot; }
    __syncthreads();
}
__device__ __forceinline__ void ln_regs(f32x4 (&v)[4], const float* g, const float* b, int lane) {
    float s = 0.f;
#pragma unroll
    for (int j = 0; j < 4; ++j) s += (v[j].x + v[j].y) + (v[j].z + v[j].w);
    const float mean = wave_sum(s) * (1.f / 1024.f); float s2 = 0.f;
#pragma unroll
    for (int j = 0; j < 4; ++j) { v[j] = v[j] - mean; s2 += (v[j].x * v[j].x + v[j].y * v[j].y) + (v[j].z * v[j].z + v[j].w * v[j].w); }
    const float rstd = 1.f / sqrtf(wave_sum(s2) * (1.f / 1024.f) + LN_EPS);
#pragma unroll
    for (int j = 0; j < 4; ++j) { const f32x4 gg = ((const GAS f32x4*)g)[lane + 64 * j], bb = ((const GAS f32x4*)b)[lane + 64 * j]; v[j] = v[j] * rstd * gg + bb; }
}
__device__ __forceinline__ void ln_route_phase(const float* Zp, const float* g, const float* b, bf16* H, const float* router, unsigned* cnt, int* tokE, int* E12, int* SL1, int* SL2, float* G1, LAS unsigned char* L, int G, int lane_in) {
    int lane = lane_in; asm volatile("" : "+v"(lane));
    const int wave = __builtin_amdgcn_readfirstlane(threadIdx.x >> 6);
    LAS int* eL = (LAS int*)L;
    for (int cb = blockIdx.x; cb < MR / 64; cb += G) {
        for (int k = 0; k < 8; ++k) {
            const int r = cb * 64 + wave * 8 + k;
            f32x4 v[4]; ln_row(Zp + (size_t)r * D, g, b, lane, v);
            store_row_bf16(H + (size_t)r * D, lane, v);
            float lg[8];
#pragma unroll
            for (int e = 0; e < 8; ++e) lg[e] = 0.f;
#pragma unroll
            for (int j = 0; j < 4; ++j)
#pragma unroll
                for (int i = 0; i < 4; ++i) { const int col = 256 * j + 4 * lane + i; const f32x4 r0 = *(const GAS f32x4*)(router + (size_t)col * 8), r1 = *(const GAS f32x4*)(router + (size_t)col * 8 + 4); const float x = v[j][i];
                    lg[0] += x * r0.x; lg[1] += x * r0.y; lg[2] += x * r0.z; lg[3] += x * r0.w; lg[4] += x * r1.x; lg[5] += x * r1.y; lg[6] += x * r1.z; lg[7] += x * r1.w; }
#pragma unroll
            for (int e = 0; e < 8; ++e) lg[e] = wave_sum(lg[e]);
            int i1 = 0; float v1 = lg[0];
#pragma unroll
            for (int e = 1; e < 8; ++e) if (lg[e] > v1) { v1 = lg[e]; i1 = e; }
            int i2 = -1; float v2 = -INFINITY;
#pragma unroll
            for (int e = 0; e < 8; ++e) if (e != i1 && lg[e] > v2) { v2 = lg[e]; i2 = e; }
            if (lane == 0) { const int ee = i1 | (i2 << 8); eL[wave * 8 + k] = ee; E12[r] = ee; G1[r] = 1.0f / (1.0f + __expf(v2 - v1)); }
        }
        __syncthreads();
        if (wave == 0) {
            const int ee = eL[lane], e1 = ee & 0xff, e2 = ee >> 8, r = cb * 64 + lane; int s1 = 0, s2 = 0;
            for (int e = 0; e < 8; ++e) {
                const bool hit = (e1 == e) || (e2 == e);
                const unsigned long long m = __ballot(hit);
                const int n = __popcll(m);
                unsigned basee = 0u; if (lane == 0 && n > 0) basee = atomicAdd(cnt + e, (unsigned)n);
                basee = (unsigned)__shfl((int)basee, 0);
                const int slot = (int)basee + __popcll(m & ((1ull << lane) - 1ull));
                if (hit) { tokE[e * 16384 + slot] = r; if (e1 == e) s1 = slot; else s2 = slot; }
            }
            SL1[r] = s1; SL2[r] = s2;
        }
        __syncthreads();
    }
}
__device__ __forceinline__ void moe_combine_phase(const bf16* H1, const bf16* OUTS, const int* E12, const int* SL1, const int* SL2, const float* G1, const LAS int* tab, const float* g, const float* b, float* out, int gw, int NGW, int lane_in) {
    int lane = lane_in; asm volatile("" : "+v"(lane));
    for (int r = gw; r < MR; r += NGW) {
        const int ee = E12[r], e1 = ee & 0xff, e2 = ee >> 8; const size_t p1 = (size_t)(tab[8 + e1] + SL1[r]), p2 = (size_t)(tab[8 + e2] + SL2[r]); const float g1 = G1[r], g2 = 1.0f - g1;
        const GAS unsigned long long* hp = (const GAS unsigned long long*)(H1 + (size_t)r * D) + lane; const GAS unsigned long long* o1 = (const GAS unsigned long long*)(OUTS + p1 * D) + lane; const GAS unsigned long long* o2 = (const GAS unsigned long long*)(OUTS + p2 * D) + lane;
        f32x4 v[4];
#pragma unroll
        for (int j = 0; j < 4; ++j) { const unsigned long long hw = hp[64 * j], aw = o1[64 * j], bw = o2[64 * j];
            const unsigned h0 = (unsigned)hw, h1 = (unsigned)(hw >> 32), a0 = (unsigned)aw, a1 = (unsigned)(aw >> 32), b0 = (unsigned)bw, b1 = (unsigned)(bw >> 32);
            v[j] = (f32x4){bfl(h0), bfh(h0), bfl(h1), bfh(h1)} * ALPHA + (f32x4){bfl(a0), bfh(a0), bfl(a1), bfh(a1)} * g1 + (f32x4){bfl(b0), bfh(b0), bfl(b1), bfh(b1)} * g2; }
        ln_regs(v, g, b, lane);
        GAS f32x4* o = (GAS f32x4*)(out + (size_t)r * D) + lane;
#pragma unroll
        for (int j = 0; j < 4; ++j) o[64 * j] = v[j];
    }
}

namespace cv {
typedef float f32x2 __attribute__((ext_vector_type(2)));
template <int I> __device__ __forceinline__ void conv_rows(f32x2 (&acc)[32], const f32x2 (&w)[31], const LAS unsigned char* base) {
    if constexpr (I < 62) {
        const unsigned xw = *(const LAS unsigned*)(base + I * 1024);
        const f32x2 x = (f32x2){bfl(xw), bfh(xw)};
#pragma unroll
        for (int t = 0; t < 32; ++t) if (I - t >= 0 && I - t <= 30) acc[t] += x * w[I - t];
        conv_rows<I + 1>(acc, w, base);
    }
}
__device__ __forceinline__ void conv_unit(int b, int c, const bf16* GLUg, bf16* COg, const float* dw, const float* db, const float* lg, const float* lb, LAS unsigned char* L) {
    int tid_ = threadIdx.x; asm volatile("" : "+v"(tid_));
    const int tid = tid_, lane = tid & 63; const int wid = __builtin_amdgcn_readfirstlane(tid >> 6);
    const int s0 = 64 * c;
    for (int idx = tid; idx < 94 * 64; idx += 512) {
        const int i = idx >> 6, ch = idx & 63; const int sp = s0 - 30 + i; int row = -1;
        if (sp >= 0) row = b * 2048 + sp; else if (sp >= -16) row = MR + b * 16 + (16 + sp);
        v4u v = (v4u){0u, 0u, 0u, 0u};
        if (row >= 0) v = *(const GAS v4u*)(GLUg + (size_t)row * 512 + ch * 8);
        *(LAS v4u*)(L + i * 1024 + ch * 16) = v;
    }
    const int cp = tid & 255, th = tid >> 8;
    f32x2 w[31];
#pragma unroll
    for (int j = 0; j < 31; ++j) w[j] = *(const GAS f32x2*)(dw + (size_t)j * 512 + 2 * cp);
    const f32x2 bias = *(const GAS f32x2*)(db + 2 * cp);
    f32x2 acc[32];
#pragma unroll
    for (int t = 0; t < 32; ++t) acc[t] = bias;
    __syncthreads();
    conv_rows<0>(acc, w, L + (32 * th) * 1024 + cp * 4);
    __syncthreads();
#pragma unroll
    for (int t = 0; t < 32; ++t) *(LAS f32x2*)(L + (32 * th + t) * 2048 + cp * 8) = acc[t];
    __syncthreads();
    f32x4 g0 = *(const GAS f32x4*)(lg + 8 * lane), g1 = *(const GAS f32x4*)(lg + 8 * lane + 4), b0 = *(const GAS f32x4*)(lb + 8 * lane), b1 = *(const GAS f32x4*)(lb + 8 * lane + 4);
    for (int k = 0; k < 8; ++k) {
        const int T = 8 * wid + k;
        f32x4 y0 = *(const LAS f32x4*)(L + T * 2048 + lane * 32), y1 = *(const LAS f32x4*)(L + T * 2048 + lane * 32 + 16);
        const float mean = wave_sum((y0.x + y0.y) + (y0.z + y0.w) + (y1.x + y1.y) + (y1.z + y1.w)) * (1.f / 512.f);
        y0 = y0 - mean; y1 = y1 - mean;
        const float rstd = 1.f / sqrtf(wave_sum((y0.x * y0.x + y0.y * y0.y) + (y0.z * y0.z + y0.w * y0.w) + (y1.x * y1.x + y1.y * y1.y) + (y1.z * y1.z + y1.w * y1.w)) * (1.f / 512.f) + LN_EPS);
        y0 = y0 * rstd * g0 + b0; y1 = y1 * rstd * g1 + b1;
        v4u o; o.x = pk2(y0.x * sigmoid_f(y0.x), y0.y * sigmoid_f(y0.y)); o.y = pk2(y0.z * sigmoid_f(y0.z), y0.w * sigmoid_f(y0.w));
        o.z = pk2(y1.x * sigmoid_f(y1.x), y1.y * sigmoid_f(y1.y)); o.w = pk2(y1.z * sigmoid_f(y1.z), y1.w * sigmoid_f(y1.w));
        *(GAS v4u*)(COg + ((size_t)b * 2048 + s0 + T) * 512 + 8 * lane) = o;
    }
    __syncthreads();
}
}

#define HB ((bf16*)(ws + WS_H))
#define QB ((bf16*)(ws + WS_Q))
#define SGA ((bf16*)(ws + WS_SGA))
#define KB ((bf16*)(ws + WS_K))
#define VB ((bf16*)(ws + WS_V))
#define GLU ((bf16*)(ws + WS_GLU))
#define SGC ((bf16*)(ws + WS_SGC))
#define CO ((bf16*)(ws + WS_CO))
#define ACT ((bf16*)(ws + WS_ACT))
#define Z ((float*)(ws + WS_Z))
#define OUTS ((bf16*)(ws + WS_OUTS))
#define TOKE ((int*)(ws + WS_TOKE))
#define E12 ((int*)(ws + WS_E12))
#define SL1 ((int*)(ws + WS_SL1))
#define SL2 ((int*)(ws + WS_SL2))
#define G1 ((float*)(ws + WS_G1))
#define CNT ((unsigned*)(ws + WS_CTL) + CW_CNT)
#define Win_t ((bf16*)(ws + WS_WIN))
#define Wap_t ((bf16*)(ws + WS_WAP))
#define Wcp_t ((bf16*)(ws + WS_WCP))
#define Wout_t ((bf16*)(ws + WS_WOUT))
#define Wgu_t ((bf16*)(ws + WS_WGU))
#define Wd_t ((bf16*)(ws + WS_WD))
#define PHASE_CTX() CArgs* ap = (CArgs*)__builtin_amdgcn_kernarg_segment_ptr(); asm volatile("" : "+s"(ap)); unsigned char* ws = ap->ws; \
    int lane = threadIdx.x & 63; asm volatile("" : "+v"(lane)); const int wave = __builtin_amdgcn_readfirstlane(threadIdx.x >> 6); \
    const int G = gridDim.x, gw = blockIdx.x * NWAVES + wave, NGW = G * NWAVES; (void)lane; (void)gw; (void)NGW; (void)ws
#define GRID_BAR() xcd_barrier(bar)
__global__ void __launch_bounds__(NWAVES * 64, 2) fwd_kernel(Args a_unused) {
    extern __shared__ __attribute__((aligned(16))) unsigned char lds[];
    LAS unsigned char* L = (LAS unsigned char*)lds;
    XcdBarrier bar;
    { PHASE_CTX();
      for (int u = threadIdx.x; u < (LDS_BYTES - LDSCTL_OFF) / 4; u += NWAVES * 64) ((LAS unsigned*)(L + LDSCTL_OFF))[u] = 0u;
      __syncthreads();
      bar = xcd_barrier_post((unsigned*)(ws + WS_CTL) + CW_BAR, (volatile LAS unsigned*)(L + MISC_OFF) + 8);
      convert_weights(ap, 0, (LAS float*)(L + wave * 16384), gw, NGW, lane);
      embed_phase(ap, HB, gw, NGW, lane); }
    GRID_BAR();

    for (int l = 0; l < 2; ++l) {
        { PHASE_CTX(); pg8::Gemm g{HB, Win_t, M, INW, 1024}; pg8::StaticOrder S; S.init(M, INW, G, (int)blockIdx.x);
          pg8::EpiWin E{QB, KB, VB, GLU, SGA, SGC};
          pg8::gemm_phase<pg8::EpiWin, pg8::StaticOrder, true, true>(L, g, S, E); }
        GRID_BAR();
        { PHASE_CTX(); for (int u = blockIdx.x; u < 256; u += G) att::attn_unit(u >> 5, (u >> 1) & 15, u & 1, QB, KB, VB, QB, ap->in[4], ap->in[10] + l * 8, L); }
        if (l == 0) { PHASE_CTX(); attn_naive_phase(QB, KB, VB, QB, ap->in[4], ap->in[10] + l * 8, (LAS float*)(L + wave * 1024), MR, MT, gw, NGW, lane); }
        { PHASE_CTX(); for (int u = blockIdx.x; u < 256; u += G) cv::conv_unit(u >> 5, u & 31, GLU, CO, ap->in[6] + (size_t)l * 31 * 512, ap->in[7] + l * 512, ap->in[8] + l * 512, ap->in[9] + l * 512, L); }
        { PHASE_CTX(); conv_naive_phase(GLU, CO, ap->in[6] + (size_t)l * 31 * 512, ap->in[7] + l * 512, ap->in[8] + l * 512, ap->in[9] + l * 512, MR, gw, NGW, lane); }
        GRID_BAR();
        for (int pass = 0; pass < 2; ++pass) {
            { PHASE_CTX(); pg8::Gemm g{pass ? CO : QB, pass ? Wcp_t : Wap_t, M, 1024, 512}; pg8::StaticOrder S; S.init(M, 1024, G, (int)blockIdx.x);
              pg8::EpiGate E{SGA, pass ? SGC : SGA, pass};
              pg8::gemm_phase<pg8::EpiGate, pg8::StaticOrder, true, true>(L, g, S, E); }
            GRID_BAR();
        }
        { PHASE_CTX(); pg8::Gemm g{SGA, Wout_t, M, 1024, 1024}; pg8::StaticOrder S; S.init(M, 1024, G, (int)blockIdx.x);
          pg8::EpiResF32 E{Z, HB, nullptr, 0, ALPHA};
          pg8::gemm_phase<pg8::EpiResF32, pg8::StaticOrder, true, true>(L, g, S, E); }
        GRID_BAR();
        if (l == 0) { PHASE_CTX(); ln_phase_bf16(Z, ap->in[14], ap->in[15], HB, nullptr, nullptr, gw, NGW, lane); }
        else { PHASE_CTX(); ln_route_phase(Z, ap->in[14] + D, ap->in[15] + D, HB, ap->in[19], CNT, TOKE, E12, SL1, SL2, G1, L, G, lane); }
        GRID_BAR();
        if (l == 0) {
            { PHASE_CTX(); pg8::Gemm g{HB, Wgu_t, M, 2 * DFF, 1024}; pg8::StaticOrder S; S.init(M, 2 * DFF, G, (int)blockIdx.x);
              pg8::EpiSwiGLU E{ACT, DFF};
              pg8::gemm_phase<pg8::EpiSwiGLU, pg8::StaticOrder, true, true>(L, g, S, E); }
            GRID_BAR();
            { PHASE_CTX(); pg8::Gemm g{ACT, Wd_t, M, 1024, DFF}; pg8::StaticOrder S; S.init(M, 1024, G, (int)blockIdx.x);
              pg8::EpiResF32 E{Z, HB, nullptr, 0, ALPHA};
              pg8::gemm_phase<pg8::EpiResF32, pg8::StaticOrder, true, true>(L, g, S, E); }
            GRID_BAR();
            { PHASE_CTX(); ln_phase_bf16(Z, ap->in[23], ap->in[24], HB, nullptr, nullptr, gw, NGW, lane); }
            { PHASE_CTX(); convert_weights(ap, 1, (LAS float*)(L + wave * 16384), gw, NGW, lane); }
            GRID_BAR();
        } else {
            { PHASE_CTX(); LAS int* tab = (LAS int*)(L + MOE_TAB_OFF); moe_tables(CNT, tab); const int tot = tab[24];
              pg8::Gemm g{HB, Wgu_t, MR, 2 * DEXP, 1024}; MoeOrder S{G, (int)blockIdx.x, tot * 11, 11, tab, TOKE};
              pg8::EpiSwiGLU E{ACT, DEXP};
              pg8::gemm_phase<pg8::EpiSwiGLU, MoeOrder, true, true, true>(L, g, S, E); }
            GRID_BAR();
            { PHASE_CTX(); const LAS int* tab = (const LAS int*)(L + MOE_TAB_OFF); const int tot = tab[24];
              pg8::Gemm g{ACT, Wd_t, MR, 1024, DEXP}; MoeOrder S{G, (int)blockIdx.x, tot * 4, 4, tab, nullptr};
              pg8::EpiOutBf16 E{OUTS, 1024};
              pg8::gemm_phase<pg8::EpiOutBf16, MoeOrder, true, true, false>(L, g, S, E); }
            GRID_BAR();
            { PHASE_CTX(); moe_combine_phase(HB, OUTS, E12, SL1, SL2, G1, (const LAS int*)(L + MOE_TAB_OFF), ap->in[23] + D, ap->in[24] + D, ap->out, gw, NGW, lane); }
        }
    }
}

extern "C" void kernel_launch(void* const* d_in, const int* in_sizes, int n_in, void* d_out, int out_size, void* d_ws, size_t ws_size, hipStream_t stream) {
    static int grid = 0;
    if (grid == 0) {
        if (n_in != 25 || out_size != MR * D || ws_size < WS_END) { fprintf(stderr, "kernel_launch: unexpected shapes (n_in %d, out %d, ws %zu, need %zu)\n", n_in, out_size, ws_size, (size_t)WS_END); grid = -1; return; }
        int dev = 0, cus = 0, per_cu = 0;
        if (hipGetDevice(&dev) != hipSuccess || hipDeviceGetAttribute(&cus, hipDeviceAttributeMultiprocessorCount, dev) != hipSuccess) { grid = -1; return; }
        if (hipFuncSetAttribute((const void*)fwd_kernel, hipFuncAttributeMaxDynamicSharedMemorySize, LDS_BYTES) != hipSuccess) { fprintf(stderr, "kernel_launch: hipFuncSetAttribute failed\n"); grid = -1; return; }
        if (hipOccupancyMaxActiveBlocksPerMultiprocessor(&per_cu, (const void*)fwd_kernel, NWAVES * 64, LDS_BYTES) != hipSuccess || per_cu < 1) { fprintf(stderr, "kernel_launch: occupancy query says %d blocks per CU\n", per_cu); grid = -1; (void)hipGetLastError(); return; }
        (void)hipGetLastError();
        grid = cus;
    }
    if (grid < 0) return;
    if (hipMemsetAsync((char*)d_ws + WS_CTL, 0, CTL_ZERO_BYTES, stream) != hipSuccess) return;
    Args a{};
    for (int i = 0; i < 25; ++i) a.in[i] = (const float*)d_in[i];
    a.out = (float*)d_out; a.ws = (unsigned char*)d_ws;
    hipLaunchKernelGGL(fwd_kernel, dim3(grid), dim3(NWAVES * 64), LDS_BYTES, stream, a);
}
```

```cpp
#include <hip/hip_runtime.h>
#include <cstdio>
#include <cstdint>
#include <cmath>
namespace pg8 {
#define PG8_LAS __attribute__((address_space(3)))
typedef unsigned short bf16_t;
typedef short bf16x8 __attribute__((ext_vector_type(8)));
typedef float f32x4 __attribute__((ext_vector_type(4)));
typedef unsigned u32x4 __attribute__((ext_vector_type(4)));
constexpr int BM = 256, BK = 64, HALF = 128, HTB = HALF * BK * 2  , STAGE_BYTES = 8 * HTB, NXCD = 8, WGM = 8;

__host__ __device__ __forceinline__ int lds_byte(int r, int c) { const int st = (r >> 4) * 2 + (c >> 5), rr = r & 15, cc = c & 31, ob = rr * 64 + cc * 2; return st * 1024 + (ob ^ (((ob >> 9) & 1) << 5)); }
__host__ __device__ __forceinline__ void stage_rc(int b, int& R, int& C) { const int st = b / 1024, sb = b % 1024, swz = sb ^ (((sb >> 9) & 1) << 5); R = (st >> 1) * 16 + swz / 64; C = (st & 1) * 32 + (swz % 64) / 2; }
__host__ __device__ __forceinline__ int perm32(int rho) { const int n = rho >> 4, i = rho & 15; return 8 * (i >> 2) + 4 * n + (i & 3); }

struct Unit { int pn, pnb, orow, nvalid; const int* gix; };
struct Gemm { const bf16_t* A; const bf16_t* Bt; int M, N, K; };

struct StaticOrder {
    int nM, nN, nwg, G, c;
    __host__ __device__ void init(int M, int N, int G_, int c_) { nM = M / BM; nN = N / BM; nwg = nM * nN; G = G_; c = c_; }
    __host__ __device__ bool next(int i, Unit& u) const {
        const long L = (long)i * G + c; if (L >= nwg) return false;
        int wgid = (int)L; { const int q = nwg / NXCD, r = nwg % NXCD, xcd = wgid % NXCD, off = wgid / NXCD; wgid = (xcd < r ? xcd * (q + 1) : r * (q + 1) + (xcd - r) * q) + off; }
        const int nig = WGM * nN, gid = wgid / nig, fm = gid * WGM, gsz = (nM - fm) < WGM ? (nM - fm) : WGM;
        u.orow = (fm + ((wgid % nig) % gsz)) * BM; u.pn = (wgid % nig) / gsz; u.pnb = u.pn; u.nvalid = BM; u.gix = nullptr; return true;
    }
    __device__ __forceinline__ void a_ready(const Unit&) const {}
    __device__ __forceinline__ void done(const Unit&) const {}
};

__device__ __forceinline__ unsigned cvt_pk_bf16(float lo, float hi) { unsigned r; asm volatile("v_cvt_pk_bf16_f32 %0, %1, %2" : "=v"(r) : "v"(lo), "v"(hi)); return r; }
typedef float f32x2 __attribute__((ext_vector_type(2)));
typedef unsigned u32x2 __attribute__((ext_vector_type(2)));
__device__ __forceinline__ float bf_lo(unsigned w) { return __builtin_bit_cast(float, w << 16); }
__device__ __forceinline__ float bf_hi(unsigned w) { return __builtin_bit_cast(float, w & 0xffff0000u); }
__device__ __forceinline__ float sigm(float x) { return __builtin_amdgcn_rcpf(1.0f + __builtin_amdgcn_exp2f(-1.4426950408889634f * x)); }
__device__ __forceinline__ u32x4 pack8(const f32x4 a, const f32x4 b) { u32x4 w; w.x = cvt_pk_bf16(a[0], a[1]); w.y = cvt_pk_bf16(a[2], a[3]); w.z = cvt_pk_bf16(b[0], b[1]); w.w = cvt_pk_bf16(b[2], b[3]); return w; }
__device__ __forceinline__ void unpack8(const u32x4 w, f32x4& a, f32x4& b) { a = (f32x4){bf_lo(w.x), bf_hi(w.x), bf_lo(w.y), bf_hi(w.y)}; b = (f32x4){bf_lo(w.z), bf_hi(w.z), bf_lo(w.w), bf_hi(w.w)}; }

struct EpiWin {
    static constexpr bool PERM = true, AFTER_DRAIN = false;
    bf16_t *Q, *Kb, *Vb, *GLU, *SGA, *SGC;
    __device__ __forceinline__ void operator()(const f32x4 (&acc)[2][2][4][2], const Unit& u, int wr, int wc, int fr, int fq) const {
        const int row0 = u.orow + wr * 64 + fr, pn = u.pn, cin = wc * 32 + 8 * fq;
#pragma unroll
        for (int ai = 0; ai < 2; ++ai)
#pragma unroll
            for (int m = 0; m < 4; ++m) { const size_t row = (size_t)(row0 + ai * HALF + m * 16);
#pragma unroll
                for (int bj = 0; bj < 2; ++bj) { const f32x4 v0 = acc[ai][bj][m][0], v1 = acc[ai][bj][m][1];
                    if (pn < 2) { *(u32x4*)(Q + row * 512 + pn * 256 + bj * HALF + cin) = pack8(v0, v1); }
                    else if (pn == 2) { bf16_t* base = bj ? Vb : Kb; *(u32x4*)(base + row * 128 + cin) = pack8(v0, v1); }
                    else if (pn < 7) { u32x2 w; w.x = cvt_pk_bf16(v0[0] * sigm(v0[1]), v0[2] * sigm(v0[3])); w.y = cvt_pk_bf16(v1[0] * sigm(v1[1]), v1[2] * sigm(v1[3]));
                        *(u32x2*)(GLU + row * 512 + (pn - 3) * 128 + bj * 64 + (cin >> 1)) = w; }
                    else { const f32x4 s0 = (f32x4){sigm(v0[0]), sigm(v0[1]), sigm(v0[2]), sigm(v0[3])}, s1 = (f32x4){sigm(v1[0]), sigm(v1[1]), sigm(v1[2]), sigm(v1[3])};
                        bf16_t* base = pn < 11 ? SGA + (pn - 7) * 256 : SGC + (pn - 11) * 256; *(u32x4*)(base + row * 1024 + bj * HALF + cin) = pack8(s0, s1); } } }
    }
};
struct EpiGate {
    static constexpr bool PERM = true, AFTER_DRAIN = false;
    bf16_t* G; const bf16_t* S; int add;
    __device__ __forceinline__ void operator()(const f32x4 (&acc)[2][2][4][2], const Unit& u, int wr, int wc, int fr, int fq) const {
        const int row0 = u.orow + wr * 64 + fr, col0 = u.pn * BM + wc * 32 + 8 * fq;
#pragma unroll
        for (int ai = 0; ai < 2; ++ai)
#pragma unroll
            for (int m = 0; m < 4; ++m) { const size_t off = (size_t)(row0 + ai * HALF + m * 16) * 1024 + col0;
#pragma unroll
                for (int bj = 0; bj < 2; ++bj) { f32x4 s0, s1; unpack8(*(const u32x4*)(S + off + bj * HALF), s0, s1);
                    f32x4 o0 = s0 * acc[ai][bj][m][0], o1 = s1 * acc[ai][bj][m][1];
                    if (add) { f32x4 g0, g1; unpack8(*(const u32x4*)(G + off + bj * HALF), g0, g1); o0 += g0; o1 += g1; }
                    *(u32x4*)(G + off + bj * HALF) = pack8(o0, o1); }
                asm volatile("" ::: "memory"); }
    }
};
struct EpiResF32 {
    static constexpr bool PERM = false, AFTER_DRAIN = false;
    float* Z; const bf16_t* H; const float* cw; int mode; float alpha;
    __device__ __forceinline__ void operator()(const f32x4 (&acc)[2][2][4][2], const Unit& u, int wr, int wc, int fr, int fq) const {
        const int row0 = u.orow + wr * 64 + fr, col0 = u.pn * BM + wc * 32 + 4 * fq;
#pragma unroll
        for (int ai = 0; ai < 2; ++ai)
#pragma unroll
            for (int m = 0; m < 4; ++m) { const int row = row0 + ai * HALF + m * 16; const size_t off = (size_t)row * 1024 + col0;
                const float c = mode ? cw[row] : 1.0f;
#pragma unroll
                for (int bj = 0; bj < 2; ++bj)
#pragma unroll
                    for (int n = 0; n < 2; ++n) { const size_t o = off + bj * HALF + n * 16; f32x4 base;
                        if (mode == 2) base = *(const f32x4*)(Z + o);
                        else { const u32x2 hw = *(const u32x2*)(H + o); base = (f32x4){bf_lo(hw.x), bf_hi(hw.x), bf_lo(hw.y), bf_hi(hw.y)} * alpha; }
                        *(f32x4*)(Z + o) = base + acc[ai][bj][m][n] * c; }
                asm volatile("" ::: "memory"); }
    }
};
struct EpiSwiGLU {
    static constexpr bool PERM = true, AFTER_DRAIN = false;
    bf16_t* O; int ldc;
    __device__ __forceinline__ void operator()(const f32x4 (&acc)[2][2][4][2], const Unit& u, int wr, int wc, int fr, int fq) const {
        const int row0 = u.orow + wr * 64 + fr, col0 = (u.pn * BM + wc * 32 + 8 * fq) >> 1;
#pragma unroll
        for (int ai = 0; ai < 2; ++ai)
#pragma unroll
            for (int m = 0; m < 4; ++m) { bf16_t* rowp = O + (size_t)(row0 + ai * HALF + m * 16) * ldc + col0;
                if (wr * 64 + fr + ai * HALF + m * 16 < u.nvalid) {
#pragma unroll
                for (int bj = 0; bj < 2; ++bj) { const f32x4 v0 = acc[ai][bj][m][0], v1 = acc[ai][bj][m][1]; u32x2 w;
                    w.x = cvt_pk_bf16(v0[0] * sigm(v0[0]) * v0[1], v0[2] * sigm(v0[2]) * v0[3]); w.y = cvt_pk_bf16(v1[0] * sigm(v1[0]) * v1[1], v1[2] * sigm(v1[2]) * v1[3]);
                    *(u32x2*)(rowp + bj * 64) = w; } } }
    }
};

struct EpiOutBf16 {
    static constexpr bool PERM = true, AFTER_DRAIN = false;
    bf16_t* O; int ldc;
    __device__ __forceinline__ void operator()(const f32x4 (&acc)[2][2][4][2], const Unit& u, int wr, int wc, int fr, int fq) const {
        const int row0 = u.orow + wr * 64 + fr, col0 = u.pn * BM + wc * 32 + 8 * fq;
#pragma unroll
        for (int ai = 0; ai < 2; ++ai)
#pragma unroll
            for (int m = 0; m < 4; ++m) { bf16_t* rowp = O + (size_t)(row0 + ai * HALF + m * 16) * ldc + col0;
                if (wr * 64 + fr + ai * HALF + m * 16 < u.nvalid) {
#pragma unroll
                for (int bj = 0; bj < 2; ++bj) *(u32x4*)(rowp + bj * HALF) = pack8(acc[ai][bj][m][0], acc[ai][bj][m][1]); } }
    }
};

template <class Epi, class Sched, bool ALIGN_EPI = false, bool SP2 = false, bool GATHER = false>
__device__ __forceinline__ void gemm_phase(PG8_LAS unsigned char* lds, const Gemm g, const Sched& S, const Epi& E) {
    int tid_ = threadIdx.x; asm volatile("" : "+v"(tid_));
    const int tid = tid_, wid = __builtin_amdgcn_readfirstlane(tid >> 6), lane = tid & 63, wr = wid >> 2, wc = wid & 3, fr = lane & 15, fq = lane >> 4;
    const int K = g.K, nt = K / BK;
    static_assert(!GATHER || SP2, "the gathered-A form exists for the SP2 loop only");
    unsigned voffA[2], voffB[2]; int gR[2], gC[2];
#pragma unroll
    for (int i = 0; i < 2; ++i) { int R, C; stage_rc(tid * 16 + i * 8192, R, C); const int Rb = Epi::PERM ? ((R & ~31) + perm32(R & 31)) : R;
        voffA[i] = (unsigned)(R * K + C) * 2u; voffB[i] = (unsigned)(Rb * K + C) * 2u; gR[i] = R; gC[i] = C; }
    unsigned cv0[2] = {0u, 0u}, cv1[2] = {0u, 0u}, nv0[2] = {0u, 0u}, nv1[2] = {0u, 0u};
#define PG8_GVOFF(U, V0, V1) do { _Pragma("unroll") for (int _i = 0; _i < 2; ++_i) { const int _lim = (U).nvalid - 1; const int _j0 = gR[_i] < _lim ? gR[_i] : _lim, _j1 = (gR[_i] + HALF) < _lim ? (gR[_i] + HALF) : _lim; \
        V0[_i] = ((unsigned)(U).gix[_j0] * (unsigned)K + (unsigned)gC[_i]) * 2u; V1[_i] = ((unsigned)(U).gix[_j1] * (unsigned)K + (unsigned)gC[_i]) * 2u; } } while (0)
    const size_t kstep = (size_t)(BK * 2);
    const size_t hstep = (size_t)HALF * K * 2;
    const size_t tstep = 2 * hstep;
    const size_t rowb = (size_t)K * 2;
    const unsigned ldsw = (unsigned)wid * 1024u;
    const int aoff = lds_byte(wr * 64 + fr, fq * 8), boff = lds_byte(wc * 32 + fr, fq * 8);
#define PG8_SA(b, h) (((b) * 2 + (h)) * HTB)
#define PG8_SB(b, h) ((4 + (b) * 2 + (h)) * HTB)
#define PG8_STAGE(bufoff, gbase, voff) do { _Pragma("unroll") for (int _i = 0; _i < 2; ++_i) \
        __builtin_amdgcn_global_load_lds((const unsigned*)((const char*)(gbase) + (voff)[_i]), (PG8_LAS unsigned*)(lds + (bufoff) + ldsw + _i * 8192), 16, 0, 0); } while (0)
#define PG8_STAGE_A(bufoff, gbase, H, V0, V1) do { if constexpr (GATHER) { if (H) PG8_STAGE(bufoff, gbase, V1); else PG8_STAGE(bufoff, gbase, V0); } else { PG8_STAGE(bufoff, (gbase) + (H) * hstep, voffA); } } while (0)
#define PG8_LDA(dst, b, h) do { _Pragma("unroll") for (int m = 0; m < 4; ++m) _Pragma("unroll") for (int k = 0; k < 2; ++k) dst[m][k] = *(const PG8_LAS bf16x8*)(lds + PG8_SA(b, h) + aoff + m * 2048 + k * 1024); } while (0)
#define PG8_LDB(dst, b, h) do { _Pragma("unroll") for (int n = 0; n < 2; ++n) _Pragma("unroll") for (int k = 0; k < 2; ++k) dst[n][k] = *(const PG8_LAS bf16x8*)(lds + PG8_SB(b, h) + boff + n * 2048 + k * 1024); } while (0)
#define PG8_MMA(ai, bj, At, Bt) do { __builtin_amdgcn_s_setprio(1); _Pragma("unroll") for (int m = 0; m < 4; ++m) _Pragma("unroll") for (int n = 0; n < 2; ++n) _Pragma("unroll") for (int k = 0; k < 2; ++k) \
        acc[ai][bj][m][n] = __builtin_amdgcn_mfma_f32_16x16x32_bf16(Bt[n][k], At[m][k], acc[ai][bj][m][n], 0, 0, 0); __builtin_amdgcn_s_setprio(0); } while (0)
#define PG8_WAIT_V(n) asm volatile("s_waitcnt vmcnt(" #n ")" ::: "memory")
#define PG8_WAIT_L(n) asm volatile("s_waitcnt lgkmcnt(" #n ")" ::: "memory")
#define PG8_BAR __builtin_amdgcn_s_barrier()
#define PG8_SCHED __builtin_amdgcn_sched_barrier(0)
    Unit cur, nxt; int ui = 0;
    if (!S.next(0, cur)) return;
    f32x4 acc[2][2][4][2];
#pragma unroll
    for (int a = 0; a < 2; ++a)
#pragma unroll
        for (int b = 0; b < 2; ++b)
#pragma unroll
            for (int m = 0; m < 4; ++m)
#pragma unroll
                for (int n = 0; n < 2; ++n) acc[a][b][m][n] = (f32x4){0.f, 0.f, 0.f, 0.f};
    bf16x8 At[4][2], B0[2][2], B1[2][2];
    const char* cA = GATHER ? (const char*)g.A : (const char*)g.A + (size_t)cur.orow * rowb; const char* cB = (const char*)g.Bt + (size_t)cur.pnb * tstep;
    if constexpr (GATHER) PG8_GVOFF(cur, cv0, cv1);
    S.a_ready(cur);
    if constexpr (SP2) {
        PG8_STAGE(PG8_SB(0, 0), cB, voffB); PG8_STAGE(PG8_SB(0, 1), cB + hstep, voffB); PG8_STAGE_A(PG8_SA(0, 0), cA, 0, cv0, cv1); PG8_STAGE_A(PG8_SA(0, 1), cA, 1, cv0, cv1);
        if (wr == 1) PG8_BAR;
        PG8_WAIT_V(2); PG8_BAR;
        PG8_STAGE(PG8_SB(1, 0), cB + kstep, voffB); PG8_STAGE_A(PG8_SA(1, 0), cA + kstep, 0, cv0, cv1); PG8_STAGE(PG8_SB(1, 1), cB + hstep + kstep, voffB);
        PG8_WAIT_V(6); PG8_BAR;
    } else {
        PG8_STAGE(PG8_SB(0, 0), cB, voffB); PG8_STAGE(PG8_SA(0, 0), cA, voffA); PG8_STAGE(PG8_SB(0, 1), cB + hstep, voffB); PG8_STAGE(PG8_SA(0, 1), cA + hstep, voffA);
        if (wr == 1) PG8_BAR;
        PG8_WAIT_V(4); PG8_BAR;
        PG8_STAGE(PG8_SB(1, 0), cB + kstep, voffB); PG8_STAGE(PG8_SA(1, 0), cA + kstep, voffA); PG8_STAGE(PG8_SB(1, 1), cB + hstep + kstep, voffB);
        PG8_WAIT_V(6); PG8_BAR;
    }
    for (;;) {
        const bool has_next = S.next(ui + 1, nxt);
        const char* nA = GATHER ? cA : (has_next ? (const char*)g.A + (size_t)nxt.orow * rowb : cA); const char* nB = has_next ? (const char*)g.Bt + (size_t)nxt.pnb * tstep : cB;
        if constexpr (GATHER) { if (has_next) PG8_GVOFF(nxt, nv0, nv1); else { nv0[0] = cv0[0]; nv0[1] = cv0[1]; nv1[0] = cv1[0]; nv1[1] = cv1[1]; } }
        for (int t = 0; t < nt; t += 2) {
            const bool last = (t == nt - 2);
            const char* a1 = cA + (size_t)(t + 1) * kstep;
            const char* a2 = last ? nA : cA + (size_t)(t + 2) * kstep; const char* b2 = last ? nB : cB + (size_t)(t + 2) * kstep;
            const char* a3 = a2 + kstep; const char* b3 = b2 + kstep;
            if (last && has_next) S.a_ready(nxt);
            unsigned xv0[2], xv1[2];
            xv0[0] = last ? nv0[0] : cv0[0]; xv0[1] = last ? nv0[1] : cv0[1]; xv1[0] = last ? nv1[0] : cv1[0]; xv1[1] = last ? nv1[1] : cv1[1];
            if constexpr (SP2) {
            PG8_LDB(B0, 0, 0); PG8_LDB(B1, 0, 1); PG8_SCHED; PG8_LDA(At, 0, 0); PG8_STAGE_A(PG8_SA(1, 1), a1, 1, cv0, cv1);
            PG8_WAIT_V(8); PG8_WAIT_L(0); PG8_BAR; PG8_MMA(0, 0, At, B0); PG8_MMA(0, 1, At, B1); PG8_BAR; PG8_SCHED;
            PG8_LDA(At, 0, 1); PG8_STAGE(PG8_SB(0, 0), b2, voffB); PG8_STAGE(PG8_SB(0, 1), b2 + hstep, voffB); PG8_STAGE_A(PG8_SA(0, 0), a2, 0, xv0, xv1);
            PG8_WAIT_V(8); PG8_WAIT_L(0); PG8_BAR; PG8_MMA(1, 0, At, B0); PG8_MMA(1, 1, At, B1); PG8_BAR; PG8_SCHED;
            PG8_LDB(B0, 1, 0); PG8_LDB(B1, 1, 1); PG8_SCHED; PG8_LDA(At, 1, 0); PG8_STAGE_A(PG8_SA(0, 1), a2, 1, xv0, xv1);
            PG8_WAIT_V(8); PG8_WAIT_L(0); PG8_BAR; PG8_MMA(0, 0, At, B0); PG8_MMA(0, 1, At, B1); PG8_BAR; PG8_SCHED;
            PG8_LDA(At, 1, 1); PG8_STAGE(PG8_SB(1, 0), b3, voffB); PG8_STAGE(PG8_SB(1, 1), b3 + hstep, voffB); PG8_STAGE_A(PG8_SA(1, 0), a3, 0, xv0, xv1);
            PG8_WAIT_V(8); PG8_WAIT_L(0); PG8_BAR; PG8_MMA(1, 0, At, B0); PG8_MMA(1, 1, At, B1); PG8_BAR; PG8_SCHED;
            } else {
            PG8_LDB(B0, 0, 0); PG8_SCHED; PG8_LDA(At, 0, 0); PG8_STAGE(PG8_SA(1, 1), a1 + hstep, voffA);
            PG8_WAIT_L(8); PG8_BAR; PG8_WAIT_L(0); PG8_MMA(0, 0, At, B0); PG8_BAR; PG8_SCHED;
            PG8_LDB(B1, 0, 1); PG8_STAGE(PG8_SB(0, 0), b2, voffB);
            PG8_BAR; PG8_WAIT_L(0); PG8_MMA(0, 1, At, B1); PG8_BAR;
            PG8_LDA(At, 0, 1); PG8_STAGE(PG8_SA(0, 0), a2, voffA);
            PG8_BAR; PG8_WAIT_L(0); PG8_MMA(1, 0, At, B0); PG8_BAR; PG8_SCHED;
            PG8_STAGE(PG8_SB(0, 1), b2 + hstep, voffB);
            PG8_WAIT_V(6); PG8_BAR; PG8_MMA(1, 1, At, B1); PG8_BAR;
            PG8_LDB(B0, 1, 0); PG8_SCHED; PG8_LDA(At, 1, 0); PG8_STAGE(PG8_SA(0, 1), a2 + hstep, voffA);
            PG8_WAIT_L(8); PG8_BAR; PG8_WAIT_L(0); PG8_MMA(0, 0, At, B0); PG8_BAR; PG8_SCHED;
            PG8_LDB(B1, 1, 1); PG8_STAGE(PG8_SB(1, 0), b3, voffB);
            PG8_BAR; PG8_WAIT_L(0); PG8_MMA(0, 1, At, B1); PG8_BAR;
            PG8_LDA(At, 1, 1); PG8_STAGE(PG8_SA(1, 0), a3, voffA);
            PG8_BAR; PG8_WAIT_L(0); PG8_MMA(1, 0, At, B0); PG8_BAR; PG8_SCHED;
            PG8_STAGE(PG8_SB(1, 1), b3 + hstep, voffB);
            PG8_WAIT_V(6); PG8_BAR; PG8_MMA(1, 1, At, B1); PG8_BAR;
            }
        }
        if constexpr (ALIGN_EPI) { if (wr == 0) PG8_BAR; }
        if constexpr (!Epi::AFTER_DRAIN) { E(acc, cur, wr, wc, fr, fq); S.done(cur); }
        if (!has_next) break;
#pragma unroll
        for (int a = 0; a < 2; ++a)
#pragma unroll
            for (int b = 0; b < 2; ++b)
#pragma unroll
                for (int m = 0; m < 4; ++m)
#pragma unroll
                    for (int n = 0; n < 2; ++n) acc[a][b][m][n] = (f32x4){0.f, 0.f, 0.f, 0.f};
        cur = nxt; cA = nA; cB = nB; ++ui; cv0[0] = nv0[0]; cv0[1] = nv0[1]; cv1[0] = nv1[0]; cv1[1] = nv1[1];
        if constexpr (ALIGN_EPI) { if (wr == 1) PG8_BAR; }
    }
    PG8_WAIT_V(0);
    if constexpr (!ALIGN_EPI) { if (wr == 0) PG8_BAR; }
    PG8_BAR;
    if constexpr (Epi::AFTER_DRAIN) { E.fused(acc, cur, wr, wc, fr, fq, lds, wid, lane); S.done(cur); }
#undef PG8_SA
#undef PG8_SB
#undef PG8_STAGE
#undef PG8_STAGE_A
#undef PG8_GVOFF
#undef PG8_LDA
#undef PG8_LDB
#undef PG8_MMA
#undef PG8_WAIT_V
#undef PG8_WAIT_L
#undef PG8_BAR
#undef PG8_SCHED
}
}
#define GAS __attribute__((address_space(1)))
#define LAS __attribute__((address_space(3)))
typedef unsigned short bf16;
typedef unsigned v4u __attribute__((ext_vector_type(4)));
typedef float f32x4 __attribute__((ext_vector_type(4)));
typedef short bf16x8 __attribute__((ext_vector_type(8)));
typedef GAS unsigned gu32;
typedef GAS unsigned long long gu64;
#define RLX_AGENT __ATOMIC_RELAXED, __HIP_MEMORY_SCOPE_AGENT
#define LDS_WAIT() asm volatile("s_waitcnt lgkmcnt(0)" ::: "memory")
#define VM_WAIT() asm volatile("s_waitcnt vmcnt(0)" ::: "memory")
__device__ __forceinline__ unsigned long long rt() { return __builtin_amdgcn_s_memrealtime(); }
__device__ __forceinline__ unsigned f2bf(float f) { unsigned u = __builtin_bit_cast(unsigned, f); return (u + 0x7fffu + ((u >> 16) & 1u)) >> 16; }
__device__ __forceinline__ unsigned pk2(float lo, float hi) { return f2bf(lo) | (f2bf(hi) << 16); }
#define XB_TMO      128
#define XB_XCNT(j)  (256  + 64 * (j))
#define XB_XSUB(j)  (1280 + 64 * (j))
#define XB_XGEN(j)  (2304 + 64 * (j))
#define XB_TOP      3328
#define XB_TOPGEN   3392
#define XCD_BAR_WORDS 3456
#define XB_SPIN_CAP (1u << 18)

__device__ __forceinline__ unsigned xb_ld(unsigned* p)              { return __hip_atomic_load(p, __ATOMIC_RELAXED, __HIP_MEMORY_SCOPE_AGENT); }
__device__ __forceinline__ unsigned xb_add(unsigned* p, unsigned v) { return __hip_atomic_fetch_add(p, v, __ATOMIC_RELAXED, __HIP_MEMORY_SCOPE_AGENT); }
__device__ __forceinline__ unsigned xb_xcc_id() { return (unsigned)__builtin_amdgcn_s_getreg((3 << 11) | 20) & 0xFu; }
#define XB_SPIN(cond, bar) do { unsigned _sp = 0; while (cond) { __builtin_amdgcn_s_sleep(1); \
    if ((++_sp & 255u) == 0u) { if (xb_ld(&(bar)[XB_TMO])) break; if (_sp > XB_SPIN_CAP) { atomicAdd(&(bar)[XB_TMO], 1u); break; } } } } while (0)

struct XcdBarrier {
    unsigned* bar; unsigned x;
    volatile LAS unsigned* st;
};

__device__ __forceinline__ XcdBarrier xcd_barrier_post(unsigned* bar, volatile LAS unsigned* st) {
    XcdBarrier b; b.bar = bar; b.x = xb_xcc_id(); b.st = st;
    if (threadIdx.x == 0) (void)xb_add(&bar[XB_XCNT(b.x)], 1u);
    return b;
}
__device__ __forceinline__ void xcd_barrier_complete(unsigned* bar, unsigned x, unsigned& nloc, unsigned& nx) {
    const unsigned G = gridDim.x * gridDim.y * gridDim.z;
    unsigned sum, cnt, mine, sp = 0u;
    for (;;) {
        sum = 0u; cnt = 0u; mine = 0u;
#pragma unroll
        for (unsigned j = 0; j < 16; ++j) { const unsigned c = xb_ld(&bar[XB_XCNT(j)]); sum += c; cnt += (c > 0u) ? 1u : 0u; mine = (j == x) ? c : mine; }
        if (sum == G) break;
        __builtin_amdgcn_s_sleep(1);
        if ((++sp & 255u) == 0u) { if (xb_ld(&bar[XB_TMO])) break; if (sp > XB_SPIN_CAP) { atomicAdd(&bar[XB_TMO], 1u); break; } }
    }
    nloc = mine > 0u ? mine : 1u; nx = cnt > 0u ? cnt : 1u;
}

__device__ __forceinline__ void xcd_barrier(const XcdBarrier& b) {
    asm volatile("s_waitcnt vmcnt(0)" ::: "memory");
    __syncthreads();
    if (threadIdx.x == 0) {
        unsigned* bar = b.bar;
        __builtin_amdgcn_s_waitcnt(0);
        unsigned nloc = b.st[0], nx = b.st[1];
        if (nloc == 0u) { xcd_barrier_complete(bar, b.x, nloc, nx); b.st[0] = nloc; b.st[1] = nx; }
        const unsigned old = xb_add(&bar[XB_XSUB(b.x)], 1u);
        const unsigned gen = old / nloc;
        if (old + 1u == (gen + 1u) * nloc) {
            __builtin_amdgcn_fence(__ATOMIC_RELEASE, "agent");
            asm volatile("s_waitcnt vmcnt(0)" ::: "memory");
            const unsigned og = xb_add(&bar[XB_TOP], 1u);
            const unsigned tg = og / nx;
            if (og + 1u == (tg + 1u) * nx) xb_add(&bar[XB_TOPGEN], 1u);
            else XB_SPIN(xb_ld(&bar[XB_TOPGEN]) == tg, bar);
            __builtin_amdgcn_fence(__ATOMIC_ACQUIRE, "agent");
            xb_add(&bar[XB_XGEN(b.x)], 1u);
            asm volatile("s_waitcnt vmcnt(0)" ::: "memory");
        } else {
            XB_SPIN(xb_ld(&bar[XB_XGEN(b.x)]) == gen, bar);
            __builtin_amdgcn_fence(__ATOMIC_ACQUIRE, "agent");
            asm volatile("s_waitcnt vmcnt(0)" ::: "memory");
        }
    }
    __syncthreads();
}

constexpr int NWAVES = 8;
constexpr int BATCH = 8, SEQ = 2048, NMETA = 16, D = 1024;
constexpr int MR = BATCH * SEQ;
constexpr int MT = MR + NMETA;
constexpr int M = 16640;
constexpr int INW = 3840, DFF = 2816, NEXP = 8, DEXP = 1408;
constexpr float ALPHA = 1.4142135623730951f;
constexpr float LN_EPS = 1e-5f;

constexpr size_t MiB = 1u << 20;
constexpr size_t WS_CTL = 0, CTL_ZERO_BYTES = 64 * 1024;
constexpr size_t WS_TOKE = 256 * 1024, WS_E12 = 768 * 1024, WS_SL1 = 832 * 1024, WS_SL2 = 896 * 1024, WS_G1 = 960 * 1024;
constexpr int CW_CNT = 8192;
constexpr size_t WS_W = 1 * MiB;
constexpr size_t WS_WIN = WS_W, WS_WAP = WS_W + 15 * MiB / 2, WS_WCP = WS_WAP + MiB, WS_WOUT = WS_WCP + MiB, WS_WGU = WS_WOUT + 2 * MiB, WS_WD = WS_WGU + 44 * MiB;
constexpr size_t AB = 79 * MiB;
constexpr size_t R1024 = (size_t)M * 1024 * 2, R512 = (size_t)M * 512 * 2, R128 = (size_t)M * 128 * 2;
constexpr size_t WS_H = AB, WS_Q = WS_H + R1024, WS_SGA = WS_Q + R512, WS_K = WS_SGA + R1024, WS_V = WS_K + R128, WS_GLU = WS_V + R128, WS_SGC = WS_GLU + R512, WS_CO = WS_SGC + R1024;
constexpr size_t WS_ACT = WS_Q;
constexpr size_t WS_Z = AB + 122 * MiB;
constexpr size_t WS_OUTS = WS_Z;
constexpr int MOE_TAB_OFF = 131072 + 1024;
constexpr size_t WS_END = WS_Z + (size_t)M * 1024 * 4;
static_assert(WS_WD + 22 * MiB <= AB && WS_CO + R512 <= WS_END && WS_ACT + (size_t)M * DFF * 2 <= WS_Z && WS_END <= 272 * MiB, "ws map");
constexpr int CW_BAR = 4096;

constexpr int RING_BYTES = 131072, LDSCTL_OFF = RING_BYTES, MISC_OFF = LDSCTL_OFF + 320, LDS_BYTES = 147456;

__device__ __forceinline__ float wave_sum(float v) {
#pragma unroll
    for (int o = 1; o < 64; o <<= 1) v += __shfl_xor(v, o);
    return v;
}
__device__ __forceinline__ float wave_max(float v) {
#pragma unroll
    for (int o = 1; o < 64; o <<= 1) v = fmaxf(v, __shfl_xor(v, o));
    return v;
}
__device__ __forceinline__ float bfl(unsigned w) { return __builtin_bit_cast(float, w << 16); }
__device__ __forceinline__ float bfh(unsigned w) { return __builtin_bit_cast(float, w & 0xffff0000u); }
__device__ __forceinline__ float sigmoid_f(float x) { return 1.0f / (1.0f + __expf(-x)); }

__device__ __forceinline__ int winmap(int n) { return n < 768 ? n : (n < 1280 ? 768 + 2 * (n - 768) : (n < 1792 ? 769 + 2 * (n - 1280) : n)); }
__device__ __forceinline__ void transpose_item(const float* W, int K, int N, bf16* WT, int mode, int roff, LAS float* scr, int item, int lane) {
    const int nblk = N / 32, kb = item / nblk, nb = item % nblk, k0 = 64 * kb, n0 = 32 * nb;
#pragma unroll 8
    for (int i = 0; i < 32; ++i) { const int kk = 2 * i + (lane >> 5); scr[kk * 33 + (lane & 31)] = W[(size_t)(k0 + kk) * N + n0 + (lane & 31)]; }
    LDS_WAIT(); asm volatile("" ::: "memory");
    const int c = lane & 7;
#pragma unroll
    for (int j = 0; j < 4; ++j) { const int n = (lane >> 3) + 8 * j; const LAS float* s = scr + (8 * c) * 33 + n;
        v4u o; o.x = pk2(s[0 * 33], s[1 * 33]); o.y = pk2(s[2 * 33], s[3 * 33]); o.z = pk2(s[4 * 33], s[5 * 33]); o.w = pk2(s[6 * 33], s[7 * 33]);
        const int nn = n0 + n, drow = mode == 0 ? roff + nn : (mode == 1 ? roff + 2 * nn : winmap(nn));
        *(GAS v4u*)(WT + (size_t)drow * K + k0 + 8 * c) = o; }
    LDS_WAIT(); asm volatile("" ::: "memory");
}
struct Args { const float* in[25]; float* out; unsigned char* ws; };
typedef __attribute__((address_space(4))) const Args CArgs;

__device__ __forceinline__ void convert_weights(CArgs* ap, int l, LAS float* scr, int gw, int NGW, int lane_in) {
    int lane = lane_in; asm volatile("" : "+v"(lane));
    unsigned char* ws = ap->ws;
    const int nC = 1920 + 256 + 256 + 512;
    const int total = nC + (l == 0 ? 3 * 1408 : 24 * 704);
    for (int it = gw; it < total; it += NGW) {
        const float* src; bf16* dst; int K, N, mode, roff, li;
        if (it < 1920) { src = ap->in[5] + (size_t)l * 1024 * INW; K = 1024; N = INW; dst = (bf16*)(ws + WS_WIN); mode = 2; roff = 0; li = it; }
        else if (it < 2176) { src = ap->in[11] + (size_t)l * 512 * 1024; K = 512; N = 1024; dst = (bf16*)(ws + WS_WAP); mode = 0; roff = 0; li = it - 1920; }
        else if (it < 2432) { src = ap->in[12] + (size_t)l * 512 * 1024; K = 512; N = 1024; dst = (bf16*)(ws + WS_WCP); mode = 0; roff = 0; li = it - 2176; }
        else if (it < 2944) { src = ap->in[13] + (size_t)l * 1024 * 1024; K = 1024; N = 1024; dst = (bf16*)(ws + WS_WOUT); mode = 0; roff = 0; li = it - 2432; }
        else if (l == 0) { const int r = it - nC, j = r / 1408; li = r % 1408;
            if (j == 0) { src = ap->in[16]; K = 1024; N = DFF; dst = (bf16*)(ws + WS_WGU); mode = 1; roff = 0; }
            else if (j == 1) { src = ap->in[17]; K = 1024; N = DFF; dst = (bf16*)(ws + WS_WGU); mode = 1; roff = 1; }
            else { src = ap->in[18]; K = DFF; N = 1024; dst = (bf16*)(ws + WS_WD); mode = 0; roff = 0; } }
        else { const int r = it - nC, j = r / 704, e = j / 3, kind = j % 3; li = r % 704;
            if (kind == 0) { src = ap->in[20] + (size_t)e * 1024 * DEXP; K = 1024; N = DEXP; dst = (bf16*)(ws + WS_WGU) + (size_t)e * 2 * DEXP * 1024; mode = 1; roff = 0; }
            else if (kind == 1) { src = ap->in[21] + (size_t)e * 1024 * DEXP; K = 1024; N = DEXP; dst = (bf16*)(ws + WS_WGU) + (size_t)e * 2 * DEXP * 1024; mode = 1; roff = 1; }
            else { src = ap->in[22] + (size_t)e * DEXP * 1024; K = DEXP; N = 1024; dst = (bf16*)(ws + WS_WD) + (size_t)e * 1024 * DEXP; mode = 0; roff = 0; } }
        transpose_item(src, K, N, dst, mode, roff, scr, li, lane);
    }
}

__device__ __forceinline__ void ln_row(const float* src, const float* g, const float* b, int lane, f32x4 (&v)[4]) {
    const GAS f32x4* xr = (const GAS f32x4*)src + lane;
    float s = 0.f;
#pragma unroll
    for (int j = 0; j < 4; ++j) { v[j] = xr[64 * j]; s += (v[j].x + v[j].y) + (v[j].z + v[j].w); }
    const float mean = wave_sum(s) * (1.f / 1024.f); float s2 = 0.f;
#pragma unroll
    for (int j = 0; j < 4; ++j) { v[j] = v[j] - mean; s2 += (v[j].x * v[j].x + v[j].y * v[j].y) + (v[j].z * v[j].z + v[j].w * v[j].w); }
    const float rstd = 1.f / sqrtf(wave_sum(s2) * (1.f / 1024.f) + LN_EPS);
#pragma unroll
    for (int j = 0; j < 4; ++j) { const f32x4 gg = ((const GAS f32x4*)g)[lane + 64 * j], bb = ((const GAS f32x4*)b)[lane + 64 * j]; v[j] = v[j] * rstd * gg + bb; }
}
__device__ __forceinline__ void store_row_bf16(bf16* dst, int lane, const f32x4 (&v)[4]) {
    GAS unsigned long long* o8 = (GAS unsigned long long*)dst + lane;
#pragma unroll
    for (int j = 0; j < 4; ++j) o8[64 * j] = (unsigned long long)pk2(v[j].x, v[j].y) | ((unsigned long long)pk2(v[j].z, v[j].w) << 32);
}
__device__ __forceinline__ void embed_phase(CArgs* ap, bf16* H, int gw, int NGW, int lane_in) {
    int lane = lane_in; asm volatile("" : "+v"(lane));
    for (int r = gw; r < M; r += NGW) {
        f32x4 v[4];
        if (r >= MT) {
#pragma unroll
            for (int j = 0; j < 4; ++j) v[j] = (f32x4){0.f, 0.f, 0.f, 0.f};
        } else {
            const float* src = r < MR ? ap->in[0] + (size_t)r * D : ap->in[1] + (size_t)((r - MR) & 15) * D;
            ln_row(src, ap->in[2], ap->in[3], lane, v);
        }
        store_row_bf16(H + (size_t)r * D, lane, v);
    }
}
__device__ __forceinline__ void ln_phase_bf16(const float* Z, const float* g, const float* b, bf16* H, const float* router, float* CW, int gw, int NGW, int lane_in) {
    int lane = lane_in; asm volatile("" : "+v"(lane));
    for (int r = gw; r < MT; r += NGW) {
        f32x4 v[4]; ln_row(Z + (size_t)r * D, g, b, lane, v);
        store_row_bf16(H + (size_t)r * D, lane, v);
        if (router) {
            float lg[8];
#pragma unroll
            for (int e = 0; e < 8; ++e) lg[e] = 0.f;
#pragma unroll
            for (int j = 0; j < 4; ++j)
#pragma unroll
                for (int i = 0; i < 4; ++i) { const int col = 256 * j + 4 * lane + i; const f32x4 r0 = *(const GAS f32x4*)(router + (size_t)col * 8), r1 = *(const GAS f32x4*)(router + (size_t)col * 8 + 4); const float x = v[j][i];
                    lg[0] += x * r0.x; lg[1] += x * r0.y; lg[2] += x * r0.z; lg[3] += x * r0.w; lg[4] += x * r1.x; lg[5] += x * r1.y; lg[6] += x * r1.z; lg[7] += x * r1.w; }
#pragma unroll
            for (int e = 0; e < 8; ++e) lg[e] = wave_sum(lg[e]);
            int i1 = 0; float v1 = lg[0];
#pragma unroll
            for (int e = 1; e < 8; ++e) if (lg[e] > v1) { v1 = lg[e]; i1 = e; }
            int i2 = -1; float v2 = -INFINITY;
#pragma unroll
            for (int e = 0; e < 8; ++e) if (e != i1 && lg[e] > v2) { v2 = lg[e]; i2 = e; }
            const float g1 = 1.0f / (1.0f + __expf(v2 - v1)), g2 = 1.0f - g1;
            if (lane < 8) CW[(size_t)lane * M + r] = lane == i1 ? g1 : (lane == i2 ? g2 : 0.f);
        }
    }
}
__device__ __forceinline__ void ln_phase_out(const float* Z, const float* g, const float* b, float* out, int gw, int NGW, int lane_in) {
    int lane = lane_in; asm volatile("" : "+v"(lane));
    for (int r = gw; r < MR; r += NGW) {
        f32x4 v[4]; ln_row(Z + (size_t)r * D, g, b, lane, v);
        GAS f32x4* o = (GAS f32x4*)(out + (size_t)r * D) + lane;
#pragma unroll
        for (int j = 0; j < 4; ++j) o[64 * j] = v[j];
    }
}

__device__ __forceinline__ int rel_bucket(int n) {
    if (n < 16) return n;
    int b = 16; b += n >= 19; b += n >= 21; b += n >= 24; b += n >= 27; b += n >= 31; b += n >= 35; b += n >= 40; b += n >= 46; b += n >= 52; b += n >= 59; b += n >= 67; b += n >= 77; b += n >= 87; b += n >= 99; b += n >= 113;
    return b;
}
__device__ __forceinline__ void attn_naive_phase(const bf16* Q, const bf16* Kb, const bf16* Vb, bf16* AO, const float* rel_bias, const float* sinks, LAS float* pl, int row_lo, int row_hi, int gw, int NGW, int lane_in) {
    int lane = lane_in; asm volatile("" : "+v"(lane));
    for (int it = gw; it < (row_hi - row_lo) * 8; it += NGW) {
        const int row = row_lo + (it >> 3), hq = it & 7, hkv = hq >> 2;
        int b, pos, s, nmeta, band_lo, nband;
        if (row < MR) { b = row >> 11; s = row & 2047; pos = 16 + s; nmeta = 16; band_lo = s - 127 < 0 ? 0 : s - 127; nband = s - band_lo + 1; }
        else { const int mi = row - MR; b = mi >> 4; pos = mi & 15; s = 0; nmeta = pos + 1; band_lo = 0; nband = 0; }
        const int nkeys = nmeta + nband;
        unsigned qw[32];
        { const GAS v4u* qp = (const GAS v4u*)(Q + (size_t)row * 512 + hq * 64);
#pragma unroll
          for (int i = 0; i < 8; ++i) { const v4u t = qp[i]; qw[4 * i] = t.x; qw[4 * i + 1] = t.y; qw[4 * i + 2] = t.z; qw[4 * i + 3] = t.w; } }
        const float sink = sinks[hq];
        float sc[3]; float mx = -INFINITY;
#pragma unroll
        for (int c = 0; c < 3; ++c) {
            const int j = c * 64 + lane; const bool valid = j < nkeys;
            const int jj = valid ? j : 0;
            const int krow = jj < nmeta ? MR + jj : b * 2048 + band_lo + (jj - nmeta);
            const int dist = jj < nmeta ? pos - jj : s - (band_lo + jj - nmeta);
            const GAS v4u* kp = (const GAS v4u*)(Kb + (size_t)krow * 128 + hkv * 64);
            float dot = 0.f;
#pragma unroll
            for (int i = 0; i < 8; ++i) { const v4u t = kp[i];
                dot += bfl(qw[4 * i]) * bfl(t.x) + bfh(qw[4 * i]) * bfh(t.x) + bfl(qw[4 * i + 1]) * bfl(t.y) + bfh(qw[4 * i + 1]) * bfh(t.y)
                     + bfl(qw[4 * i + 2]) * bfl(t.z) + bfh(qw[4 * i + 2]) * bfh(t.z) + bfl(qw[4 * i + 3]) * bfl(t.w) + bfh(qw[4 * i + 3]) * bfh(t.w); }
            sc[c] = valid ? dot * 0.125f + rel_bias[rel_bucket(dist) * 8 + hq] : -INFINITY;
            mx = fmaxf(mx, sc[c]);
        }
        mx = fmaxf(wave_max(mx), sink);
        float ps = 0.f;
#pragma unroll
        for (int c = 0; c < 3; ++c) { const float p = __expf(sc[c] - mx); ps += p; pl[c * 64 + lane] = p; }
        const float denom = wave_sum(ps) + __expf(sink - mx);
        LDS_WAIT(); asm volatile("" ::: "memory");
        float o = 0.f;
#pragma unroll 8
        for (int j = 0; j < nkeys; ++j) {
            const int krow = j < nmeta ? MR + j : b * 2048 + band_lo + (j - nmeta);
            o += pl[j] * bfl((unsigned)Vb[(size_t)krow * 128 + hkv * 64 + lane]);
        }
        LDS_WAIT(); asm volatile("" ::: "memory");
        AO[(size_t)row * 512 + hq * 64 + lane] = (bf16)f2bf(o / denom);
    }
}

namespace att {
typedef short bf16x8 __attribute__((ext_vector_type(8)));
typedef short s16x4 __attribute__((ext_vector_type(4)));
typedef float f32x16 __attribute__((ext_vector_type(16)));
typedef float f32x2_t __attribute__((ext_vector_type(2))); typedef __bf16 bf16x2_t __attribute__((ext_vector_type(2)));
constexpr int NK = 288, NG = 18;
constexpr int LK = 0, LV = NK * 128, LBIAS = 2 * NK * 128, LWS = LBIAS + 2048, LOST = LWS + 2048, LEND = LOST + 32768;
__device__ __forceinline__ int crow(int r, int hi) { return (r & 3) + 8 * (r >> 2) + 4 * hi; }
__device__ __forceinline__ unsigned cvtpk_s(float lo, float hi) { f32x2_t v = {lo, hi}; bf16x2_t b = __builtin_convertvector(v, bf16x2_t); return __builtin_bit_cast(unsigned, b); }
typedef __attribute__((address_space(3))) const char* lds_cptr;
typedef short v4i16_t __attribute__((ext_vector_type(4)));
__device__ __forceinline__ s16x4 vtr(lds_cptr p) { return __builtin_bit_cast(s16x4, __builtin_amdgcn_ds_read_tr16_b64_v4i16((__attribute__((address_space(3))) v4i16_t*)p)); }

__device__ __forceinline__ void attn_unit(int b, int n, int hkv, const bf16* Q, const bf16* Kg, const bf16* Vg, bf16* AO, const float* relb, const float* sinks, LAS unsigned char* L) {
    int tid_ = threadIdx.x; asm volatile("" : "+v"(tid_));
    const int tid = tid_, lane = tid & 63, r32 = lane & 31, hi = lane >> 5; const int wid = __builtin_amdgcn_readfirstlane(tid >> 6);
    { const int g = tid >> 7, dist = tid & 127; ((LAS float*)(L + LBIAS))[tid] = relb[rel_bucket(dist) * 8 + hkv * 4 + g]; }
    for (int idx = tid; idx < NK * 8; idx += 512) {
        const int key = idx >> 3, c = idx & 7; int row = -1;
        if (key < 16) row = MR + key;
        else if (key >= 32) { const int sp = (n - 1) * 128 + (key - 32); if (sp >= 0) row = b * 2048 + sp; }
        v4u kv = (v4u){0u, 0u, 0u, 0u}, vv = (v4u){0u, 0u, 0u, 0u};
        if (row >= 0) { kv = *(const GAS v4u*)(Kg + (size_t)row * 128 + hkv * 64 + c * 8); vv = *(const GAS v4u*)(Vg + (size_t)row * 128 + hkv * 64 + c * 8); }
        *(LAS v4u*)(L + LK + c * (NK * 16) + key * 16) = kv;
        *(LAS v4u*)(L + LV + ((c >> 2) * NG + (key >> 4)) * 1024 + (key & 15) * 64 + (c & 3) * 16) = vv;
    }
    __syncthreads();
    const int g = wid >> 1, qh = wid & 1, hq = hkv * 4 + g;
    const float sink = sinks[hq];
    const LAS float* biasT = (const LAS float*)(L + LBIAS) + g * 128;
    LAS float* wsf = (LAS float*)(L + LWS) + wid * 64;
    LAS bf16* stg = (LAS bf16*)(L + LOST) + wid * 2048;
    const int voff = ((lane >> 4) & 1) * 32 + (lane & 3) * 8 + (4 * hi + ((lane & 15) >> 2)) * 64;
    for (int sb = 0; sb < 2; ++sb) {
        const int a0 = 64 * qh + 32 * sb, a = a0 + r32, t0 = a0 >> 5;
        const size_t qrow = (size_t)b * 2048 + n * 128 + a;
        bf16x8 qr[4];
#pragma unroll
        for (int d0 = 0; d0 < 4; ++d0) qr[d0] = *(const GAS bf16x8*)(Q + qrow * 512 + hq * 64 + d0 * 16 + hi * 8);
        f32x16 S[6];
#pragma unroll
        for (int jt = 0; jt < 6; ++jt) { const int kt = jt == 0 ? 0 : t0 + jt; f32x16 acc = {};
#pragma unroll
            for (int d0 = 0; d0 < 4; ++d0) { const bf16x8 kf = *(const LAS bf16x8*)(L + LK + (d0 * 2 + hi) * (NK * 16) + (kt * 32 + r32) * 16); acc = __builtin_amdgcn_mfma_f32_32x32x16_bf16(kf, qr[d0], acc, 0, 0, 0); }
            S[jt] = acc; }
        const int posq = 16 + n * 128 + a; float mx = -INFINITY;
#pragma unroll
        for (int r = 0; r < 16; ++r) { const int m = crow(r, hi); const bool valid = m < 16; const int dist = posq - m; const int di = valid ? (dist > 127 ? 127 : dist) : 0;
            const float bs = biasT[di]; const float v = valid ? S[0][r] * 0.125f + bs : -INFINITY; S[0][r] = v; mx = fmaxf(mx, v); }
#pragma unroll
        for (int jt = 1; jt < 6; ++jt)
#pragma unroll
            for (int r = 0; r < 16; ++r) { const int kk = 32 * (t0 + jt - 1) + crow(r, hi); const int dist = 128 + a - kk; const bool valid = dist >= 0 && dist < 128 && (n > 0 || kk >= 128);
                const float bs = biasT[valid ? dist : 0]; const float v = valid ? S[jt][r] * 0.125f + bs : -INFINITY; S[jt][r] = v; mx = fmaxf(mx, v); }
        mx = fmaxf(mx, __shfl_xor(mx, 32)); const float mrow = fmaxf(mx, sink);
        float l = 0.f;
#pragma unroll
        for (int jt = 0; jt < 6; ++jt)
#pragma unroll
            for (int r = 0; r < 16; ++r) { const float p = __expf(S[jt][r] - mrow); S[jt][r] = p; l += p; }
        l += __shfl_xor(l, 32); l += __expf(sink - mrow);
        f32x16 o[2]; o[0] = f32x16{}; o[1] = f32x16{};
#pragma unroll
        for (int jt = 0; jt < 6; ++jt) { const int kt = jt == 0 ? 0 : t0 + jt;
#pragma unroll
            for (int h2 = 0; h2 < 2; ++h2) { v4u pw; pw.x = cvtpk_s(S[jt][8 * h2 + 0], S[jt][8 * h2 + 1]); pw.y = cvtpk_s(S[jt][8 * h2 + 2], S[jt][8 * h2 + 3]); pw.z = cvtpk_s(S[jt][8 * h2 + 4], S[jt][8 * h2 + 5]); pw.w = cvtpk_s(S[jt][8 * h2 + 6], S[jt][8 * h2 + 7]);
                const bf16x8 pa = __builtin_bit_cast(bf16x8, pw); const int grp = 2 * kt + h2;
#pragma unroll
                for (int dh = 0; dh < 2; ++dh) { const lds_cptr vp = (lds_cptr)(L + LV + (dh * NG + grp) * 1024 + voff); const s16x4 lo = vtr(vp), hh = vtr(vp + 512);
                    const bf16x8 vf = (bf16x8){lo[0], lo[1], lo[2], lo[3], hh[0], hh[1], hh[2], hh[3]}; o[dh] = __builtin_amdgcn_mfma_f32_32x32x16_bf16(pa, vf, o[dh], 0, 0, 0); } } }
        if (hi == 0) wsf[r32] = l;
        LDS_WAIT(); asm volatile("" ::: "memory");
#pragma unroll
        for (int r = 0; r < 16; ++r) { const int q = crow(r, hi); const float rl = 1.0f / wsf[q];
#pragma unroll
            for (int dh = 0; dh < 2; ++dh) stg[q * 64 + dh * 32 + r32] = (bf16)f2bf(o[dh][r] * rl); }
        LDS_WAIT(); asm volatile("" ::: "memory");
#pragma unroll
        for (int i = 0; i < 4; ++i) { const int row = i * 8 + (lane >> 3), ch = lane & 7; const v4u v = *(const LAS v4u*)(stg + row * 64 + ch * 8);
            *(GAS v4u*)(AO + ((size_t)b * 2048 + n * 128 + a0 + row) * 512 + hq * 64 + ch * 8) = v; }
        LDS_WAIT(); asm volatile("" ::: "memory");
    }
    __syncthreads();
}
}

__device__ __forceinline__ void conv_naive_phase(const bf16* GLU, bf16* CO, const float* dw, const float* db, const float* lg, const float* lb, int row_lo, int gw, int NGW, int lane_in) {
    int lane = lane_in; asm volatile("" : "+v"(lane));
    for (int row = row_lo + gw; row < M; row += NGW) {
        if (row >= MT) { *(GAS v4u*)(CO + (size_t)row * 512 + 8 * lane) = (v4u){0u, 0u, 0u, 0u}; continue; }
        int b, pos;
        if (row < MR) { b = row >> 11; pos = 16 + (row & 2047); } else { const int mi = row - MR; b = mi >> 4; pos = mi & 15; }
        float acc[8];
        { const f32x4 b0 = *(const GAS f32x4*)(db + 8 * lane), b1 = *(const GAS f32x4*)(db + 8 * lane + 4); acc[0] = b0.x; acc[1] = b0.y; acc[2] = b0.z; acc[3] = b0.w; acc[4] = b1.x; acc[5] = b1.y; acc[6] = b1.z; acc[7] = b1.w; }
        for (int j = 0; j < 31; ++j) {
            const int p = pos - 30 + j; if (p < 0) continue;
            const int r2 = p < 16 ? MR + p : b * 2048 + p - 16;
            const v4u t = *(const GAS v4u*)(GLU + (size_t)r2 * 512 + 8 * lane);
            const f32x4 w0 = *(const GAS f32x4*)(dw + (size_t)j * 512 + 8 * lane), w1 = *(const GAS f32x4*)(dw + (size_t)j * 512 + 8 * lane + 4);
            acc[0] += bfl(t.x) * w0.x; acc[1] += bfh(t.x) * w0.y; acc[2] += bfl(t.y) * w0.z; acc[3] += bfh(t.y) * w0.w;
            acc[4] += bfl(t.z) * w1.x; acc[5] += bfh(t.z) * w1.y; acc[6] += bfl(t.w) * w1.z; acc[7] += bfh(t.w) * w1.w;
        }
        float s = 0.f;
#pragma unroll
        for (int i = 0; i < 8; ++i) s += acc[i];
        const float mean = wave_sum(s) * (1.f / 512.f); float s2 = 0.f;
#pragma unroll
        for (int i = 0; i < 8; ++i) { acc[i] -= mean; s2 += acc[i] * acc[i]; }
        const float rstd = 1.f / sqrtf(wave_sum(s2) * (1.f / 512.f) + LN_EPS);
        float y[8];
#pragma unroll
        for (int i = 0; i < 8; ++i) { const float t = acc[i] * rstd * lg[8 * lane + i] + lb[8 * lane + i]; y[i] = t * sigmoid_f(t); }
        v4u o; o.x = pk2(y[0], y[1]); o.y = pk2(y[2], y[3]); o.z = pk2(y[4], y[5]); o.w = pk2(y[6], y[7]);
        *(GAS v4u*)(CO + (size_t)row * 512 + 8 * lane) = o;
    }
}


struct MoeOrder {
    int G, c, nU, ncol; const LAS int* tab; const int* tokE;
    __device__ __forceinline__ bool next(int i, pg8::Unit& u) const {
        const int Lx = i * G + c; if (Lx >= nU) return false;
        int wgid; { const int q = nU / 8, r = nU % 8, xcd = Lx % 8, off = Lx / 8; wgid = (xcd < r ? xcd * (q + 1) : r * (q + 1) + (xcd - r) * q) + off; }
        int e = 0, rem = wgid;
        for (; e < 7; ++e) { const int ue = tab[e] * ncol; if (rem < ue) break; rem -= ue; }
        const int nt = tab[e], pml = rem % nt, pn = rem / nt, left = tab[16 + e] - 256 * pml;
        u.pn = pn; u.pnb = e * ncol + pn; u.orow = tab[8 + e] + 256 * pml; u.nvalid = left < 256 ? left : 256; u.gix = tokE ? tokE + e * 16384 + 256 * pml : nullptr; return true;
    }
    __device__ __forceinline__ void a_ready(const pg8::Unit&) const {}
    __device__ __forceinline__ void done(const pg8::Unit&) const {}
};
__device__ __forceinline__ void moe_tables(const unsigned* cnt, LAS int* tab) {
    if (threadIdx.x == 0) { int run = 0, tot = 0;
        for (int e = 0; e < 8; ++e) { const int c = (int)cnt[e]; tab[16 + e] = c; tab[8 + e] = run; run += c; const int nt = (c + 255) >> 8; tab[e] = nt; tot += nt; }
        tab[24] = tot; }
    __syncthreads();
}
__device__ __forceinline__ void ln_regs(f32x4 (&v)[4], const float* g, const float* b, int lane) {
    float s = 0.f;
#pragma unroll
    for (int j = 0; j < 4; ++j) s += (v[j].x + v[j].y) + (v[j].z + v[j].w);
    const float mean = wave_sum(s) * (1.f / 1024.f); float s2 = 0.f;
#pragma unroll
    for (int j = 0; j < 4; ++j) { v[j] = v[j] - mean; s2 += (v[j].x * v[j].x + v[j].y * v[j].y) + (v[j].z * v[j].z + v[j].w * v[j].w); }
    const float rstd = 1.f / sqrtf(wave_sum(s2) * (1.f / 1024.f) + LN_EPS);
#pragma unroll
    for (int j = 0; j < 4; ++j) { const f32x4 gg = ((const GAS f32x4*)g)[lane + 64 * j], bb = ((const GAS f32x4*)b)[lane + 64 * j]; v[j] = v[j] * rstd * gg + bb; }
}
__device__ __forceinline__ void ln_route_phase(const float* Zp, const float* g, const float* b, bf16* H, const float* router, unsigned* cnt, int* tokE, int* E12, int* SL1, int* SL2, float* G1, LAS unsigned char* L, int G, int lane_in) {
    int lane = lane_in; asm volatile("" : "+v"(lane));
    const int wave = __builtin_amdgcn_readfirstlane(threadIdx.x >> 6);
    LAS int* eL = (LAS int*)L;
    for (int cb = blockIdx.x; cb < MR / 64; cb += G) {
        for (int k = 0; k < 8; ++k) {
            const int r = cb * 64 + wave * 8 + k;
            f32x4 v[4]; ln_row(Zp + (size_t)r * D, g, b, lane, v);
            store_row_bf16(H + (size_t)r * D, lane, v);
            float lg[8];
#pragma unroll
            for (int e = 0; e < 8; ++e) lg[e] = 0.f;
#pragma unroll
            for (int j = 0; j < 4; ++j)
#pragma unroll
                for (int i = 0; i < 4; ++i) { const int col = 256 * j + 4 * lane + i; const f32x4 r0 = *(const GAS f32x4*)(router + (size_t)col * 8), r1 = *(const GAS f32x4*)(router + (size_t)col * 8 + 4); const float x = v[j][i];
                    lg[0] += x * r0.x; lg[1] += x * r0.y; lg[2] += x * r0.z; lg[3] += x * r0.w; lg[4] += x * r1.x; lg[5] += x * r1.y; lg[6] += x * r1.z; lg[7] += x * r1.w; }
#pragma unroll
            for (int e = 0; e < 8; ++e) lg[e] = wave_sum(lg[e]);
            int i1 = 0; float v1 = lg[0];
#pragma unroll
            for (int e = 1; e < 8; ++e) if (lg[e] > v1) { v1 = lg[e]; i1 = e; }
            int i2 = -1; float v2 = -INFINITY;
#pragma unroll
            for (int e = 0; e < 8; ++e) if (e != i1 && lg[e] > v2) { v2 = lg[e]; i2 = e; }
            if (lane == 0) { const int ee = i1 | (i2 << 8); eL[wave * 8 + k] = ee; E12[r] = ee; G1[r] = 1.0f / (1.0f + __expf(v2 - v1)); }
        }
        __syncthreads();
        if (wave == 0) {
            const int ee = eL[lane], e1 = ee & 0xff, e2 = ee >> 8, r = cb * 64 + lane; int s1 = 0, s2 = 0;
            for (int e = 0; e < 8; ++e) {
                const bool hit = (e1 == e) || (e2 == e);
                const unsigned long long m = __ballot(hit);
                const int n = __popcll(m);
                unsigned basee = 0u; if (lane == 0 && n > 0) basee = atomicAdd(cnt + e, (unsigned)n);
                basee = (unsigned)__shfl((int)basee, 0);
                const int slot = (int)basee + __popcll(m & ((1ull << lane) - 1ull));
                if (hit) { tokE[e * 16384 + slot] = r; if (e1 == e) s1 = slot; else s2 = slot; }
            }
            SL1[r] = s1; SL2[r] = s2;
        }
        __syncthreads();
    }
}
__device__ __forceinline__ void moe_combine_phase(const bf16* H1, const bf16* OUTS, const int* E12, const int* SL1, const int* SL2, const float* G1, const LAS int* tab, const float* g, const float* b, float* out, int gw, int NGW, int lane_in) {
    int lane = lane_in; asm volatile("" : "+v"(lane));
    for (int r = gw; r < MR; r += NGW) {
        const int ee = E12[r], e1 = ee & 0xff, e2 = ee >> 8; const size_t p1 = (size_t)(tab[8 + e1] + SL1[r]), p2 = (size_t)(tab[8 + e2] + SL2[r]); const float g1 = G1[r], g2 = 1.0f - g1;
        const GAS unsigned long long* hp = (const GAS unsigned long long*)(H1 + (size_t)r * D) + lane; const GAS unsigned long long* o1 = (const GAS unsigned long long*)(OUTS + p1 * D) + lane; const GAS unsigned long long* o2 = (const GAS unsigned long long*)(OUTS + p2 * D) + lane;
        f32x4 v[4];
#pragma unroll
        for (int j = 0; j < 4; ++j) { const unsigned long long hw = hp[64 * j], aw = o1[64 * j], bw = o2[64 * j];
            const unsigned h0 = (unsigned)hw, h1 = (unsigned)(hw >> 32), a0 = (unsigned)aw, a1 = (unsigned)(aw >> 32), b0 = (unsigned)bw, b1 = (unsigned)(bw >> 32);
            v[j] = (f32x4){bfl(h0), bfh(h0), bfl(h1), bfh(h1)} * ALPHA + (f32x4){bfl(a0), bfh(a0), bfl(a1), bfh(a1)} * g1 + (f32x4){bfl(b0), bfh(b0), bfl(b1), bfh(b1)} * g2; }
        ln_regs(v, g, b, lane);
        GAS f32x4* o = (GAS f32x4*)(out + (size_t)r * D) + lane;
#pragma unroll
        for (int j = 0; j < 4; ++j) o[64 * j] = v[j];
    }
}

namespace cv {
typedef float f32x2 __attribute__((ext_vector_type(2)));
template <int I> __device__ __forceinline__ void conv_rows(f32x2 (&acc)[32], const f32x2 (&w)[31], const LAS unsigned char* base) {
    if constexpr (I < 62) {
        const unsigned xw = *(const LAS unsigned*)(base + I * 1024);
        const f32x2 x = (f32x2){bfl(xw), bfh(xw)};
#pragma unroll
        for (int t = 0; t < 32; ++t) if (I - t >= 0 && I - t <= 30) acc[t] += x * w[I - t];
        conv_rows<I + 1>(acc, w, base);
    }
}
__device__ __forceinline__ void conv_unit(int b, int c, const bf16* GLUg, bf16* COg, const float* dw, const float* db, const float* lg, const float* lb, LAS unsigned char* L) {
    int tid_ = threadIdx.x; asm volatile("" : "+v"(tid_));
    const int tid = tid_, lane = tid & 63; const int wid = __builtin_amdgcn_readfirstlane(tid >> 6);
    const int s0 = 64 * c;
    for (int idx = tid; idx < 94 * 64; idx += 512) {
        const int i = idx >> 6, ch = idx & 63; const int sp = s0 - 30 + i; int row = -1;
        if (sp >= 0) row = b * 2048 + sp; else if (sp >= -16) row = MR + (16 + sp);
        v4u v = (v4u){0u, 0u, 0u, 0u};
        if (row >= 0) v = *(const GAS v4u*)(GLUg + (size_t)row * 512 + ch * 8);
        *(LAS v4u*)(L + i * 1024 + ch * 16) = v;
    }
    const int cp = tid & 255, th = tid >> 8;
    f32x2 w[31];
#pragma unroll
    for (int j = 0; j < 31; ++j) w[j] = *(const GAS f32x2*)(dw + (size_t)j * 512 + 2 * cp);
    const f32x2 bias = *(const GAS f32x2*)(db + 2 * cp);
    f32x2 acc[32];
#pragma unroll
    for (int t = 0; t < 32; ++t) acc[t] = bias;
    __syncthreads();
    conv_rows<0>(acc, w, L + (32 * th) * 1024 + cp * 4);
    __syncthreads();
#pragma unroll
    for (int t = 0; t < 32; ++t) *(LAS f32x2*)(L + (32 * th + t) * 2048 + cp * 8) = acc[t];
    __syncthreads();
    f32x4 g0 = *(const GAS f32x4*)(lg + 8 * lane), g1 = *(const GAS f32x4*)(lg + 8 * lane + 4), b0 = *(const GAS f32x4*)(lb + 8 * lane), b1 = *(const GAS f32x4*)(lb + 8 * lane + 4);
    for (int k = 0; k < 8; ++k) {
        const int T = 8 * wid + k;
        f32x4 y0 = *(const LAS f32x4*)(L + T * 2048 + lane * 32), y1 = *(const LAS f32x4*)(L + T * 2048 + lane * 32 + 16);
        const float mean = wave_sum((y0.x + y0.y) + (y0.z + y0.w) + (y1.x + y1.y) + (y1.z + y1.w)) * (1.f / 512.f);
        y0 = y0 - mean; y1 = y1 - mean;
        const float rstd = 1.f / sqrtf(wave_sum((y0.x * y0.x + y0.y * y0.y) + (y0.z * y0.z + y0.w * y0.w) + (y1.x * y1.x + y1.y * y1.y) + (y1.z * y1.z + y1.w * y1.w)) * (1.f / 512.f) + LN_EPS);
        y0 = y0 * rstd * g0 + b0; y1 = y1 * rstd * g1 + b1;
        v4u o; o.x = pk2(y0.x * sigmoid_f(y0.x), y0.y * sigmoid_f(y0.y)); o.y = pk2(y0.z * sigmoid_f(y0.z), y0.w * sigmoid_f(y0.w));
        o.z = pk2(y1.x * sigmoid_f(y1.x), y1.y * sigmoid_f(y1.y)); o.w = pk2(y1.z * sigmoid_f(y1.z), y1.w * sigmoid_f(y1.w));
        *(GAS v4u*)(COg + ((size_t)b * 2048 + s0 + T) * 512 + 8 * lane) = o;
    }
    __syncthreads();
}
}

#define HB ((bf16*)(ws + WS_H))
#define QB ((bf16*)(ws + WS_Q))
#define SGA ((bf16*)(ws + WS_SGA))
#define KB ((bf16*)(ws + WS_K))
#define VB ((bf16*)(ws + WS_V))
#define GLU ((bf16*)(ws + WS_GLU))
#define SGC ((bf16*)(ws + WS_SGC))
#define CO ((bf16*)(ws + WS_CO))
#define ACT ((bf16*)(ws + WS_ACT))
#define Z ((float*)(ws + WS_Z))
#define OUTS ((bf16*)(ws + WS_OUTS))
#define TOKE ((int*)(ws + WS_TOKE))
#define E12 ((int*)(ws + WS_E12))
#define SL1 ((int*)(ws + WS_SL1))
#define SL2 ((int*)(ws + WS_SL2))
#define G1 ((float*)(ws + WS_G1))
#define CNT ((unsigned*)(ws + WS_CTL) + CW_CNT)
#define Win_t ((bf16*)(ws + WS_WIN))
#define Wap_t ((bf16*)(ws + WS_WAP))
#define Wcp_t ((bf16*)(ws + WS_WCP))
#define Wout_t ((bf16*)(ws + WS_WOUT))
#define Wgu_t ((bf16*)(ws + WS_WGU))
#define Wd_t ((bf16*)(ws + WS_WD))

namespace mg {
typedef short bf16x8 __attribute__((ext_vector_type(8)));
template <int KSTEPS> __device__ __forceinline__ f32x4 mini_acc(const bf16* A, int lda, const bf16* Bt, int ldb, int n0, int k0, int lane) {
    const bf16* ap = A + (size_t)(lane & 15) * lda + k0 + 8 * (lane >> 4);
    const bf16* bp = Bt + (size_t)(n0 + (lane & 15)) * ldb + k0 + 8 * (lane >> 4);
    bf16x8 a[KSTEPS], b[KSTEPS];
#pragma unroll
    for (int s = 0; s < KSTEPS; ++s) { a[s] = *(const GAS bf16x8*)(ap + 32 * s); b[s] = *(const GAS bf16x8*)(bp + 32 * s); }
    f32x4 acc = (f32x4){0.f, 0.f, 0.f, 0.f};
#pragma unroll
    for (int s = 0; s < KSTEPS; ++s) acc = __builtin_amdgcn_mfma_f32_16x16x32_bf16(a[s], b[s], acc, 0, 0, 0);
    return acc;
}
template <int MODE> __device__ __forceinline__ void meta_block(int cg_in, unsigned char* ws, LAS unsigned char* L) {
    int cg = cg_in; asm volatile("" : "+s"(cg));
    if (cg >= 64) return;
    int tid_ = threadIdx.x; asm volatile("" : "+v"(tid_));
    const int lane = tid_ & 63; const int wave = __builtin_amdgcn_readfirstlane(tid_ >> 6);
    f32x4 a1, a2;
    if constexpr (MODE == 3) { a1 = mini_acc<2>(QB + (size_t)MR * 512, 512, Wap_t, 512, cg * 16, wave * 64, lane); a2 = mini_acc<2>(CO + (size_t)MR * 512, 512, Wcp_t, 512, cg * 16, wave * 64, lane); }
    else if constexpr (MODE == 4) a1 = mini_acc<4>(SGA + (size_t)MR * 1024, 1024, Wout_t, 1024, cg * 16, wave * 128, lane);
    else a1 = mini_acc<11>(ACT + (size_t)MR * DFF, DFF, Wd_t, DFF, cg * 16, wave * 352, lane);
    LAS f32x4* red = (LAS f32x4*)L;
    red[(wave * 64 + lane) * 2] = a1; if constexpr (MODE == 3) red[(wave * 64 + lane) * 2 + 1] = a2;
    __syncthreads();
    if (wave == 0) {
        f32x4 s1 = (f32x4){0.f, 0.f, 0.f, 0.f}, s2 = s1;
#pragma unroll
        for (int w = 0; w < 8; ++w) { s1 += red[(w * 64 + lane) * 2]; if constexpr (MODE == 3) s2 += red[(w * 64 + lane) * 2 + 1]; }
        const int n = cg * 16 + (lane & 15);
#pragma unroll
        for (int i = 0; i < 4; ++i) { const size_t o = (size_t)(MR + 4 * (lane >> 4) + i) * 1024 + n;
            if constexpr (MODE == 3) SGA[o] = (bf16)f2bf(bfl((unsigned)SGA[o]) * s1[i] + bfl((unsigned)SGC[o]) * s2[i]);
            else Z[o] = ALPHA * bfl((unsigned)HB[o]) + s1[i]; }
    }
    __syncthreads();
}
}

#define PHASE_CTX() CArgs* ap = (CArgs*)__builtin_amdgcn_kernarg_segment_ptr(); asm volatile("" : "+s"(ap)); unsigned char* ws = ap->ws; \
    int lane = threadIdx.x & 63; asm volatile("" : "+v"(lane)); const int wave = __builtin_amdgcn_readfirstlane(threadIdx.x >> 6); \
    int bid = blockIdx.x; asm volatile("" : "+s"(bid)); int G = gridDim.x; asm volatile("" : "+s"(G)); const int gw = bid * NWAVES + wave, NGW = G * NWAVES; (void)lane; (void)gw; (void)NGW; (void)ws
#define GRID_BAR() xcd_barrier(bar)
__global__ void __launch_bounds__(NWAVES * 64, 2) fwd_kernel(Args a_unused) {
    extern __shared__ __attribute__((aligned(16))) unsigned char lds[];
    LAS unsigned char* L = (LAS unsigned char*)lds;
    XcdBarrier bar;
    { PHASE_CTX();
      for (int u = threadIdx.x; u < (LDS_BYTES - LDSCTL_OFF) / 4; u += NWAVES * 64) ((LAS unsigned*)(L + LDSCTL_OFF))[u] = 0u;
      __syncthreads();
      bar = xcd_barrier_post((unsigned*)(ws + WS_CTL) + CW_BAR, (volatile LAS unsigned*)(L + MISC_OFF) + 8);
      convert_weights(ap, 0, (LAS float*)(L + wave * 16384), gw, NGW, lane);
      embed_phase(ap, HB, gw, NGW, lane); }
    GRID_BAR();

    for (int l = 0; l < 2; ++l) {
        { PHASE_CTX(); pg8::Gemm g{HB, Win_t, M, INW, 1024}; pg8::StaticOrder S; S.init(M, INW, G, bid);
          pg8::EpiWin E{QB, KB, VB, GLU, SGA, SGC};
          pg8::gemm_phase<pg8::EpiWin, pg8::StaticOrder, true, true>(L, g, S, E); }
        GRID_BAR();
        { PHASE_CTX(); for (int u = bid; u < 256; u += G) att::attn_unit(u >> 5, (u >> 1) & 15, u & 1, QB, KB, VB, QB, ap->in[4], ap->in[10] + l * 8, L); }
        if (l == 0) { PHASE_CTX(); attn_naive_phase(QB, KB, VB, QB, ap->in[4], ap->in[10] + l * 8, (LAS float*)(L + wave * 1024), MR, MT, gw, NGW, lane); }
        { PHASE_CTX(); for (int u = bid; u < 256; u += G) cv::conv_unit(u >> 5, u & 31, GLU, CO, ap->in[6] + (size_t)l * 31 * 512, ap->in[7] + l * 512, ap->in[8] + l * 512, ap->in[9] + l * 512, L); }
        { PHASE_CTX(); conv_naive_phase(GLU, CO, ap->in[6] + (size_t)l * 31 * 512, ap->in[7] + l * 512, ap->in[8] + l * 512, ap->in[9] + l * 512, MR, gw, NGW, lane); }
        GRID_BAR();
        if (l == 0) { PHASE_CTX(); mg::meta_block<3>(bid, ws, L); }
        for (int pass = 0; pass < 2; ++pass) {
            { PHASE_CTX(); pg8::Gemm g{pass ? CO : QB, pass ? Wcp_t : Wap_t, MR, 1024, 512}; pg8::StaticOrder S; S.init(MR, 1024, G, bid);
              pg8::EpiGate E{SGA, pass ? SGC : SGA, pass};
              pg8::gemm_phase<pg8::EpiGate, pg8::StaticOrder, true, true>(L, g, S, E); }
            GRID_BAR();
        }
        if (l == 0) { PHASE_CTX(); mg::meta_block<4>(bid, ws, L); }
        { PHASE_CTX(); pg8::Gemm g{SGA, Wout_t, MR, 1024, 1024}; pg8::StaticOrder S; S.init(MR, 1024, G, bid);
          pg8::EpiResF32 E{Z, HB, nullptr, 0, ALPHA};
          pg8::gemm_phase<pg8::EpiResF32, pg8::StaticOrder, true, true>(L, g, S, E); }
        GRID_BAR();
        if (l == 0) { PHASE_CTX(); ln_phase_bf16(Z, ap->in[14], ap->in[15], HB, nullptr, nullptr, gw, NGW, lane); }
        else { PHASE_CTX(); ln_route_phase(Z, ap->in[14] + D, ap->in[15] + D, HB, ap->in[19], CNT, TOKE, E12, SL1, SL2, G1, L, G, lane); }
        GRID_BAR();
        if (l == 0) {
            { PHASE_CTX(); pg8::Gemm g{HB, Wgu_t, M, 2 * DFF, 1024}; pg8::StaticOrder S; S.init(M, 2 * DFF, G, bid);
              pg8::EpiSwiGLU E{ACT, DFF};
              pg8::gemm_phase<pg8::EpiSwiGLU, pg8::StaticOrder, true, true>(L, g, S, E); }
            GRID_BAR();
            { PHASE_CTX(); mg::meta_block<6>(bid, ws, L); }
            { PHASE_CTX(); pg8::Gemm g{ACT, Wd_t, MR, 1024, DFF}; pg8::StaticOrder S; S.init(MR, 1024, G, bid);
              pg8::EpiResF32 E{Z, HB, nullptr, 0, ALPHA};
              pg8::gemm_phase<pg8::EpiResF32, pg8::StaticOrder, true, true>(L, g, S, E); }
            GRID_BAR();
            { PHASE_CTX(); ln_phase_bf16(Z, ap->in[23], ap->in[24], HB, nullptr, nullptr, gw, NGW, lane); }
            { PHASE_CTX(); convert_weights(ap, 1, (LAS float*)(L + wave * 16384), gw, NGW, lane); }
            GRID_BAR();
        } else {
            { PHASE_CTX(); LAS int* tab = (LAS int*)(L + MOE_TAB_OFF); moe_tables(CNT, tab); const int tot = tab[24];
              pg8::Gemm g{HB, Wgu_t, MR, 2 * DEXP, 1024}; MoeOrder S{G, bid, tot * 11, 11, tab, TOKE};
              pg8::EpiSwiGLU E{ACT, DEXP};
              pg8::gemm_phase<pg8::EpiSwiGLU, MoeOrder, true, true, true>(L, g, S, E); }
            GRID_BAR();
            { PHASE_CTX(); const LAS int* tab = (const LAS int*)(L + MOE_TAB_OFF); const int tot = tab[24];
              pg8::Gemm g{ACT, Wd_t, MR, 1024, DEXP}; MoeOrder S{G, bid, tot * 4, 4, tab, nullptr};
              pg8::EpiOutBf16 E{OUTS, 1024};
              pg8::gemm_phase<pg8::EpiOutBf16, MoeOrder, true, true, false>(L, g, S, E); }
            GRID_BAR();
            { PHASE_CTX(); moe_combine_phase(HB, OUTS, E12, SL1, SL2, G1, (const LAS int*)(L + MOE_TAB_OFF), ap->in[23] + D, ap->in[24] + D, ap->out, gw, NGW, lane); }
        }
    }
}

extern "C" void kernel_launch(void* const* d_in, const int* in_sizes, int n_in, void* d_out, int out_size, void* d_ws, size_t ws_size, hipStream_t stream) {
    static int grid = 0;
    if (grid == 0) {
        if (n_in != 25 || out_size != MR * D || ws_size < WS_END) { fprintf(stderr, "kernel_launch: unexpected shapes (n_in %d, out %d, ws %zu, need %zu)\n", n_in, out_size, ws_size, (size_t)WS_END); grid = -1; return; }
        int dev = 0, cus = 0, per_cu = 0;
        if (hipGetDevice(&dev) != hipSuccess || hipDeviceGetAttribute(&cus, hipDeviceAttributeMultiprocessorCount, dev) != hipSuccess) { grid = -1; return; }
        if (hipFuncSetAttribute((const void*)fwd_kernel, hipFuncAttributeMaxDynamicSharedMemorySize, LDS_BYTES) != hipSuccess) { fprintf(stderr, "kernel_launch: hipFuncSetAttribute failed\n"); grid = -1; return; }
        if (hipOccupancyMaxActiveBlocksPerMultiprocessor(&per_cu, (const void*)fwd_kernel, NWAVES * 64, LDS_BYTES) != hipSuccess || per_cu < 1) { fprintf(stderr, "kernel_launch: occupancy query says %d blocks per CU\n", per_cu); grid = -1; (void)hipGetLastError(); return; }
        (void)hipGetLastError();
        grid = cus;
    }
    if (grid < 0) return;
    if (hipMemsetAsync((char*)d_ws + WS_CTL, 0, CTL_ZERO_BYTES, stream) != hipSuccess) return;
    Args a{};
    for (int i = 0; i < 25; ++i) a.in[i] = (const float*)d_in[i];
    a.out = (float*)d_out; a.ws = (unsigned char*)d_ws;
    hipLaunchKernelGGL(fwd_kernel, dim3(grid), dim3(NWAVES * 64), LDS_BYTES, stream, a);
}
```
